# Optimizing an MI355X kernel written in HIP

```python
import math
import jax
import jax.numpy as jnp
from jax import lax
import numpy as np

D_MODEL = 1024
BATCH = 2
SEQ = 8192
DEPTH = 4

D_MIX = 1024
FOX_HEADS = 6
FOX_HEAD_DIM = 64
FOX_WIDTH = FOX_HEADS * FOX_HEAD_DIM
Q_BLOCK = 128
GLA_HEADS = 4
GLA_DV = 96
GLA_DK = 48
GLA_KWIDTH = GLA_HEADS * GLA_DK
GLA_VWIDTH = GLA_HEADS * GLA_DV
GLA_GATE_RANK = 16
GLA_GATE_TAU = 16.0
GLA_CHUNK = 64
POOL_WINDOWS = (2, 4, 8, 16)
POOL_GROUP = 64
POOL_WIDTH = len(POOL_WINDOWS) * POOL_GROUP
IN_SPLITS = (FOX_WIDTH, FOX_WIDTH, FOX_WIDTH, FOX_HEADS,
             GLA_KWIDTH, GLA_KWIDTH, GLA_VWIDTH, GLA_VWIDTH, GLA_GATE_RANK,
             POOL_WIDTH)
IN_OFFSETS = tuple(int(o) for o in np.cumsum(IN_SPLITS)[:-1])
N_IN = sum(IN_SPLITS)
FORGET_OFFSET = 3 * FOX_WIDTH
N_EXPERTS = 32
TOP_K = 4
D_EXPERT = 1024
SWIGLU_ALPHA = 1.702
SWIGLU_LIMIT = 7.0
MOE_BLOCK = 256
N_MOD = 6
LN_EPS = 1e-5
RMS_EPS = 1e-6
DEEPNORM_ALPHA = (2 * DEPTH) ** 0.25
DEEPNORM_BETA = (8 * DEPTH) ** -0.25

kernel_name = 'hybrid_fox_gla_pool_moe_deepnorm'


def layer_norm(x, g, b):
    xf = x.astype(jnp.float32)
    mu = jnp.mean(xf, axis=-1, keepdims=True)
    var = jnp.mean(jnp.square(xf - mu), axis=-1, keepdims=True)
    return ((xf - mu) * lax.rsqrt(var + LN_EPS)).astype(x.dtype) * g + b


def forgetting_attention(q, k, v, f_logit):
    B, S, H, Dh = q.shape
    nb = S // Q_BLOCK
    scale = Dh ** -0.5
    F = jnp.cumsum(jax.nn.log_sigmoid(f_logit.astype(jnp.float32)), axis=1).transpose(0, 2, 1)
    k_t = k.transpose(0, 2, 1, 3)
    v_t = v.transpose(0, 2, 1, 3)
    q_blocks = q.reshape(B, nb, Q_BLOCK, H, Dh).transpose(1, 0, 3, 2, 4)
    F_blocks = F.reshape(B, H, nb, Q_BLOCK).transpose(2, 0, 1, 3)
    k_pos = jnp.arange(S)

    def block(args):
        qb, Fq, i = args
        q_pos = i * Q_BLOCK + jnp.arange(Q_BLOCK)
        s = jnp.einsum('bhqd,bhkd->bhqk', qb, k_t, preferred_element_type=jnp.float32) * scale
        s = s + Fq[..., None] - F[:, :, None, :]
        s = jnp.where(k_pos[None, :] <= q_pos[:, None], s, -jnp.inf)
        p = jax.nn.softmax(s, axis=-1)
        return jnp.einsum('bhqk,bhkd->bhqd', p.astype(v.dtype), v_t)

    o = lax.map(block, (q_blocks, F_blocks, jnp.arange(nb)))
    return o.transpose(1, 0, 3, 2, 4).reshape(B, S, H * Dh)


def gla_chunked(q, k, v, log_a):
    B, S, H, Dk = q.shape
    Dv = v.shape[-1]
    C = GLA_CHUNK
    n = S // C

    def chunk(t):
        return t.astype(jnp.float32).reshape(B, n, C, H, -1).transpose(0, 3, 1, 2, 4)

    qc, kc, vc, ac = chunk(q) * (Dk ** -0.5), chunk(k), chunk(v), chunk(log_a)
    b = jnp.cumsum(ac, axis=3)
    b_last = b[:, :, :, -1:, :]
    q_in = qc * jnp.exp(b)
    k_in = kc * jnp.exp(-b)
    k_out = kc * jnp.exp(b_last - b)
    causal = jnp.tril(jnp.ones((C, C), dtype=bool))
    attn = jnp.where(causal, jnp.einsum('bhnid,bhnjd->bhnij', q_in, k_in), 0.0)
    o_intra = jnp.einsum('bhnij,bhnjv->bhniv', attn, vc)
    kv = jnp.einsum('bhncd,bhncv->bhndv', k_out, vc)
    decay = jnp.exp(b_last[:, :, :, 0, :])

    def step(state, inp):
        kv_n, dec_n = inp
        return state * dec_n[..., None] + kv_n, state

    init = jnp.zeros((B, H, Dk, Dv), jnp.float32)
    _, states = lax.scan(step, init, (kv.transpose(2, 0, 1, 3, 4), decay.transpose(2, 0, 1, 3)))
    o_inter = jnp.einsum('bhncd,nbhdv->bhncv', q_in, states)
    o = o_intra + o_inter
    return o.transpose(0, 2, 3, 1, 4).reshape(B, S, H, Dv)


def multiscale_pool(u, w_pool, pool_scale):
    B, S, W = u.shape
    uf = u.astype(jnp.float32)
    cs = jnp.concatenate([jnp.zeros((B, 1, W), jnp.float32), jnp.cumsum(uf, axis=1)], axis=1)
    win = jnp.repeat(jnp.array(POOL_WINDOWS, jnp.int32), POOL_GROUP)
    pos = jnp.arange(S, dtype=jnp.int32)
    lo_idx = jnp.maximum(pos[:, None] + 1 - win[None, :], 0)
    lo = jnp.take_along_axis(cs, jnp.broadcast_to(lo_idx[None], (B, S, W)), axis=1)
    count = jnp.minimum(pos[:, None] + 1, win[None, :]).astype(jnp.float32)
    pooled = (cs[:, 1:] - lo) / count[None] - uf
    pooled = pooled.reshape(B, S, len(POOL_WINDOWS), POOL_GROUP)
    mixed = jnp.einsum('bsgc,gcd->bsgd', pooled, w_pool.astype(jnp.float32)).reshape(B, S, W)
    return (mixed * pool_scale.astype(jnp.float32)).astype(u.dtype)


def hybrid_mixer(h, w_in, b_in, gla_w_a2, gla_b_a, gla_norm_g, pool_w, pool_scale, w_out):
    B, S, _ = h.shape
    z = h @ w_in + b_in
    fq, fk, fv, ff, gq, gk, gv, gr, ga1, pu = jnp.split(z, IN_OFFSETS, axis=-1)
    hd = (B, S, FOX_HEADS, FOX_HEAD_DIM)
    o_fox = forgetting_attention(fq.reshape(hd), fk.reshape(hd), fv.reshape(hd), ff)
    log_a = jax.nn.log_sigmoid((ga1 @ gla_w_a2 + gla_b_a).astype(jnp.float32)) / GLA_GATE_TAU
    kd = (B, S, GLA_HEADS, GLA_DK)
    o = gla_chunked(gq.reshape(kd), gk.reshape(kd), gv.reshape(B, S, GLA_HEADS, GLA_DV), log_a.reshape(kd))
    o = o * lax.rsqrt(jnp.mean(jnp.square(o), axis=-1, keepdims=True) + RMS_EPS)
    o_gla = (o.reshape(B, S, GLA_VWIDTH).astype(h.dtype) * gla_norm_g) * jax.nn.silu(gr)
    o_pool = multiscale_pool(pu, pool_w, pool_scale)
    return jnp.concatenate([o_fox, o_gla, o_pool], axis=-1) @ w_out


def clamped_swiglu(gu):
    glu, lin = jnp.split(gu, 2, axis=-1)
    glu = jnp.minimum(glu, SWIGLU_LIMIT)
    lin = jnp.clip(lin, -SWIGLU_LIMIT, SWIGLU_LIMIT)
    return glu * jax.nn.sigmoid(SWIGLU_ALPHA * glu) * (lin + 1.0)


def moe_ffn(h, w_router, b_router, w_gate_up, b_gate_up, w_down, b_down):
    B, S, D = h.shape
    T = B * S
    hf = h.reshape(T, D)
    logits = (hf @ w_router + b_router).astype(jnp.float32)
    top_logit, top_e = lax.top_k(logits, TOP_K)
    gate = jax.nn.softmax(top_logit, axis=-1)
    M = T * TOP_K
    flat_e = top_e.reshape(M)
    order = jnp.argsort(flat_e)
    sorted_e = flat_e[order]
    token_of = (order // TOP_K).astype(jnp.int32)
    counts = jnp.bincount(flat_e, length=N_EXPERTS)
    padded = (counts + MOE_BLOCK - 1) // MOE_BLOCK * MOE_BLOCK
    group_start = jnp.cumsum(counts) - counts
    padded_end = jnp.cumsum(padded)
    padded_start = padded_end - padded
    dest = padded_start[sorted_e] + jnp.arange(M) - group_start[sorted_e]
    n_blocks = -(-M // MOE_BLOCK) + N_EXPERTS
    rows = n_blocks * MOE_BLOCK
    row_token = jnp.full((rows,), T, jnp.int32).at[dest].set(token_of)
    h_pad = jnp.concatenate([hf, jnp.zeros((1, D), hf.dtype)], axis=0)
    x_rows = h_pad[row_token].reshape(n_blocks, MOE_BLOCK, D)
    block_expert = jnp.minimum(
        jnp.searchsorted(padded_end, jnp.arange(n_blocks) * MOE_BLOCK, side='right'), N_EXPERTS - 1)

    def expert_block(args):
        xb, e = args
        gu = xb @ w_gate_up[e] + b_gate_up[e]
        return clamped_swiglu(gu) @ w_down[e] + b_down[e]

    y_rows = lax.map(expert_block, (x_rows, block_expert)).reshape(rows, D)
    y = y_rows[dest] * gate.reshape(M)[order][:, None].astype(h.dtype)
    out = jnp.zeros((T, D), h.dtype).at[token_of].add(y)
    return out.reshape(B, S, D)


def setup_inputs(seed: int = 0) -> dict:
    key = jax.random.key(seed)
    ks = jax.random.split(key, 24)
    nrm = jax.random.normal
    f32 = jnp.float32
    L, D = DEPTH, D_MODEL
    x = nrm(ks[0], (BATCH, SEQ, D), f32)
    c = nrm(ks[1], (BATCH, D), f32)
    w_ada = nrm(ks[2], (L, D, N_MOD * D), f32) * (0.1 * D ** -0.5)
    b_ada = nrm(ks[3], (L, N_MOD * D), f32) * 0.02
    w_in = nrm(ks[4], (L, D, N_IN), f32) * D ** -0.5
    b_in = nrm(ks[5], (L, N_IN), f32) * 0.02
    b_in = b_in.at[:, FORGET_OFFSET:FORGET_OFFSET + FOX_HEADS].set(
        2.0 + 0.5 * nrm(ks[6], (L, FOX_HEADS), f32))
    gla_w_a2 = nrm(ks[7], (L, GLA_GATE_RANK, GLA_KWIDTH), f32) * GLA_GATE_RANK ** -0.5
    gla_b_a = nrm(ks[8], (L, GLA_KWIDTH), f32) * 0.1
    gla_norm_g = 1.0 + 0.02 * nrm(ks[9], (L, GLA_VWIDTH), f32)
    pool_w = nrm(ks[10], (L, len(POOL_WINDOWS), POOL_GROUP, POOL_GROUP), f32) * POOL_GROUP ** -0.5
    pool_scale = 1.0 + 0.02 * nrm(ks[11], (L, POOL_WIDTH), f32)
    w_out = nrm(ks[12], (L, D_MIX, D), f32) * (D_MIX ** -0.5 * DEEPNORM_BETA)
    ln1_g = 1.0 + 0.02 * nrm(ks[13], (L, D), f32)
    ln1_b = 0.02 * nrm(ks[14], (L, D), f32)
    w_router = nrm(ks[15], (L, D, N_EXPERTS), f32) * D ** -0.5
    b_router = 0.01 * nrm(ks[16], (L, N_EXPERTS), f32)
    w_gate_up = nrm(ks[17], (L, N_EXPERTS, D, 2 * D_EXPERT), f32) * D ** -0.5
    b_gate_up = 0.02 * nrm(ks[18], (L, N_EXPERTS, 2 * D_EXPERT), f32)
    w_down = nrm(ks[19], (L, N_EXPERTS, D_EXPERT, D), f32) * (D_EXPERT ** -0.5 * DEEPNORM_BETA)
    b_down = 0.02 * nrm(ks[20], (L, N_EXPERTS, D), f32)
    ln2_g = 1.0 + 0.02 * nrm(ks[21], (L, D), f32)
    ln2_b = 0.02 * nrm(ks[22], (L, D), f32)
    return {'x': x, 'c': c, 'w_ada': w_ada, 'b_ada': b_ada, 'w_in': w_in, 'b_in': b_in,
            'gla_w_a2': gla_w_a2, 'gla_b_a': gla_b_a, 'gla_norm_g': gla_norm_g,
            'pool_w': pool_w, 'pool_scale': pool_scale, 'w_out': w_out,
            'ln1_g': ln1_g, 'ln1_b': ln1_b, 'w_router': w_router, 'b_router': b_router,
            'w_gate_up': w_gate_up, 'b_gate_up': b_gate_up, 'w_down': w_down, 'b_down': b_down,
            'ln2_g': ln2_g, 'ln2_b': ln2_b}


def reference(x, c, w_ada, b_ada, w_in, b_in, gla_w_a2, gla_b_a, gla_norm_g, pool_w, pool_scale,
              w_out, ln1_g, ln1_b, w_router, b_router, w_gate_up, b_gate_up, w_down, b_down,
              ln2_g, ln2_b):
    cond = jax.nn.silu(c)
    for l in range(DEPTH):
        mod = cond @ w_ada[l] + b_ada[l]
        shift1, scale1, gate1, shift2, scale2, gate2 = [m[:, None, :] for m in jnp.split(mod, N_MOD, axis=-1)]
        h = x * (1.0 + scale1) + shift1
        y = hybrid_mixer(h, w_in[l], b_in[l], gla_w_a2[l], gla_b_a[l], gla_norm_g[l],
                         pool_w[l], pool_scale[l], w_out[l])
        x = layer_norm(DEEPNORM_ALPHA * x + (1.0 + gate1) * y, ln1_g[l], ln1_b[l])
        h = x * (1.0 + scale2) + shift2
        y = moe_ffn(h, w_router[l], b_router[l], w_gate_up[l], b_gate_up[l], w_down[l], b_down[l])
        x = layer_norm(DEEPNORM_ALPHA * x + (1.0 + gate2) * y, ln2_g[l], ln2_b[l])
    return x
```

```cpp
#include <hip/hip_runtime.h>
#include <hip/hip_bf16.h>
#include <cstdio>
#include <cstdint>
#include <cmath>
__device__ __forceinline__ int opaque_tid() { int t = threadIdx.x; asm volatile("" : "+v"(t)); return t; }
#ifndef MK_ONE_LAUNCH
#define MK_ONE_LAUNCH 0
#endif
namespace pg8 {
#define PG8_LAS __attribute__((address_space(3)))
typedef unsigned short bf16_t;
typedef short bf16x8 __attribute__((ext_vector_type(8)));
typedef float f32x4 __attribute__((ext_vector_type(4)));
typedef unsigned u32x4 __attribute__((ext_vector_type(4)));
constexpr int BM = 256, BK = 64, HALF = 128, HTB = HALF * BK * 2  , STAGE_BYTES = 8 * HTB, NXCD = 8, WGM = 8;

__host__ __device__ __forceinline__ int lds_byte(int r, int c) { const int st = (r >> 4) * 2 + (c >> 5), rr = r & 15, cc = c & 31, ob = rr * 64 + cc * 2; return st * 1024 + (ob ^ (((ob >> 9) & 1) << 5)); }
__host__ __device__ __forceinline__ void stage_rc(int b, int& R, int& C) { const int st = b / 1024, sb = b % 1024, swz = sb ^ (((sb >> 9) & 1) << 5); R = (st >> 1) * 16 + swz / 64; C = (st & 1) * 32 + (swz % 64) / 2; }
__host__ __device__ __forceinline__ int perm32(int rho) { const int n = rho >> 4, i = rho & 15; return 8 * (i >> 2) + 4 * n + (i & 3); }

struct Unit { int pm, pn; };
struct Gemm { const bf16_t* A; const bf16_t* Bt; int M, N, K; };

struct StaticOrder {
    int nM, nN, nwg, G, c;
    __host__ __device__ void init(int M, int N, int G_, int c_) { nM = M / BM; nN = N / BM; nwg = nM * nN; G = G_; c = c_; }
    __host__ __device__ bool next(int i, Unit& u) const {
        const long L = (long)i * G + c; if (L >= nwg) return false;
        int wgid = (int)L; { const int q = nwg / NXCD, r = nwg % NXCD, xcd = wgid % NXCD, off = wgid / NXCD; wgid = (xcd < r ? xcd * (q + 1) : r * (q + 1) + (xcd - r) * q) + off; }
        const int nig = WGM * nN, gid = wgid / nig, fm = gid * WGM, gsz = (nM - fm) < WGM ? (nM - fm) : WGM;
        u.pm = fm + ((wgid % nig) % gsz); u.pn = (wgid % nig) / gsz; return true;
    }
    __device__ __forceinline__ void a_ready(const Unit&) const {}
    __device__ __forceinline__ void done(const Unit&) const {}
};

__device__ __forceinline__ unsigned cvt_pk_bf16(float lo, float hi) { unsigned r; asm volatile("v_cvt_pk_bf16_f32 %0, %1, %2" : "=v"(r) : "v"(lo), "v"(hi)); return r; }
typedef float f32x2 __attribute__((ext_vector_type(2)));
struct EpiF32 {
    static constexpr bool PERM = false, AFTER_DRAIN = false;
    float* C; int ldc; const float* bias;
    __device__ __forceinline__ void operator()(const f32x4 (&acc)[2][2][4][2], const Unit& u, int wr, int wc, int fr, int fq) const {
        const int row0 = u.pm * BM + wr * 64 + fr, col0 = u.pn * BM + wc * 32 + 4 * fq;
        f32x4 bv[2][2];
#pragma unroll
        for (int bj = 0; bj < 2; ++bj)
#pragma unroll
            for (int n = 0; n < 2; ++n) bv[bj][n] = bias ? *(const f32x4*)(bias + col0 + bj * HALF + n * 16) : (f32x4){0.f, 0.f, 0.f, 0.f};
#pragma unroll
        for (int ai = 0; ai < 2; ++ai)
#pragma unroll
            for (int m = 0; m < 4; ++m) { float* rowp = C + (size_t)(row0 + ai * HALF + m * 16) * ldc + col0;
#pragma unroll
                for (int bj = 0; bj < 2; ++bj)
#pragma unroll
                    for (int n = 0; n < 2; ++n) *(f32x4*)(rowp + bj * HALF + n * 16) = acc[ai][bj][m][n] + bv[bj][n]; }
    }
};
struct EpiZ {
    static constexpr bool PERM = true, AFTER_DRAIN = false;
    bf16_t* Z; float* ZF; const float* bias;
    __device__ __forceinline__ void operator()(const f32x4 (&acc)[2][2][4][2], const Unit& u, int wr, int wc, int fr, int fq) const {
        const int row0 = u.pm * BM + wr * 64 + fr;
        if (u.pn < 10) {
            const int col0 = u.pn * BM + wc * 32 + 8 * fq;
            f32x4 bv[2][2];
#pragma unroll
            for (int bj = 0; bj < 2; ++bj)
#pragma unroll
                for (int n = 0; n < 2; ++n) bv[bj][n] = *(const f32x4*)(bias + col0 + bj * HALF + 4 * n);
#pragma unroll
            for (int ai = 0; ai < 2; ++ai)
#pragma unroll
                for (int m = 0; m < 4; ++m) { bf16_t* rowp = Z + (size_t)(row0 + ai * HALF + m * 16) * 2560 + col0;
#pragma unroll
                    for (int bj = 0; bj < 2; ++bj) { const f32x4 v0 = acc[ai][bj][m][0] + bv[bj][0], v1 = acc[ai][bj][m][1] + bv[bj][1];
                        u32x4 w; w.x = cvt_pk_bf16(v0[0], v0[1]); w.y = cvt_pk_bf16(v0[2], v0[3]); w.z = cvt_pk_bf16(v1[0], v1[1]); w.w = cvt_pk_bf16(v1[2], v1[3]);
                        *(u32x4*)(rowp + bj * HALF) = w; } }
        } else if (wc == 0) {
            const f32x4 b0 = *(const f32x4*)(bias + 2560 + 8 * fq), b1 = *(const f32x4*)(bias + 2560 + 8 * fq + 4);
#pragma unroll
            for (int ai = 0; ai < 2; ++ai)
#pragma unroll
                for (int m = 0; m < 4; ++m) { float* rp = ZF + (size_t)(row0 + ai * HALF + m * 16) * 32 + 8 * fq;
                    *(f32x4*)rp = acc[ai][0][m][0] + b0; *(f32x4*)(rp + 4) = acc[ai][0][m][1] + b1; }
        }
    }
};
struct EpiSwiglu {
    static constexpr bool PERM = true, AFTER_DRAIN = false;
    bf16_t* ACT; const float* bgu;
    __device__ __forceinline__ void operator()(const f32x4 (&acc)[2][2][4][2], const Unit& u, int wr, int wc, int fr, int fq) const {
        const int e = u.pn >> 3, pnl = u.pn & 7;
        const int row0 = u.pm * BM + wr * 64 + fr, col0 = pnl * 128 + wc * 32 + 8 * fq;
        const float* bg = bgu + (size_t)e * 2048 + col0;
        const f32x4 bg0 = *(const f32x4*)bg, bg1 = *(const f32x4*)(bg + 4), bl0 = *(const f32x4*)(bg + 1024), bl1 = *(const f32x4*)(bg + 1028);
#pragma unroll
        for (int ai = 0; ai < 2; ++ai)
#pragma unroll
            for (int m = 0; m < 4; ++m) {
                f32x4 g0 = acc[ai][0][m][0] + bg0, g1 = acc[ai][0][m][1] + bg1, l0 = acc[ai][1][m][0] + bl0, l1 = acc[ai][1][m][1] + bl1;
                float o[8];
#pragma unroll
                for (int j = 0; j < 4; ++j) {
                    float g = fminf(g0[j], 7.0f), l = fminf(fmaxf(l0[j], -7.0f), 7.0f);
                    o[j] = g * __builtin_amdgcn_rcpf(1.0f + __expf(-1.702f * g)) * (l + 1.0f);
                    g = fminf(g1[j], 7.0f); l = fminf(fmaxf(l1[j], -7.0f), 7.0f);
                    o[4 + j] = g * __builtin_amdgcn_rcpf(1.0f + __expf(-1.702f * g)) * (l + 1.0f);
                }
                u32x4 w; w.x = cvt_pk_bf16(o[0], o[1]); w.y = cvt_pk_bf16(o[2], o[3]); w.z = cvt_pk_bf16(o[4], o[5]); w.w = cvt_pk_bf16(o[6], o[7]);
                *(u32x4*)(ACT + (size_t)(row0 + ai * HALF + m * 16) * 1024 + col0) = w;
            }
    }
};
struct EpiDown {
    static constexpr bool PERM = true, AFTER_DRAIN = false;
    bf16_t* Y; const float* bdn;
    __device__ __forceinline__ void operator()(const f32x4 (&acc)[2][2][4][2], const Unit& u, int wr, int wc, int fr, int fq) const {
        const int e = u.pn >> 2, pnl = u.pn & 3;
        const int row0 = u.pm * BM + wr * 64 + fr, col0 = pnl * BM + wc * 32 + 8 * fq;
        f32x4 bv[2][2];
#pragma unroll
        for (int bj = 0; bj < 2; ++bj)
#pragma unroll
            for (int n = 0; n < 2; ++n) bv[bj][n] = *(const f32x4*)(bdn + (size_t)e * 1024 + col0 + bj * HALF + 4 * n);
#pragma unroll
        for (int ai = 0; ai < 2; ++ai)
#pragma unroll
            for (int m = 0; m < 4; ++m) { bf16_t* rowp = Y + (size_t)(row0 + ai * HALF + m * 16) * 1024 + col0;
#pragma unroll
                for (int bj = 0; bj < 2; ++bj) { const f32x4 v0 = acc[ai][bj][m][0] + bv[bj][0], v1 = acc[ai][bj][m][1] + bv[bj][1];
                    u32x4 w; w.x = cvt_pk_bf16(v0[0], v0[1]); w.y = cvt_pk_bf16(v0[2], v0[3]); w.z = cvt_pk_bf16(v1[0], v1[1]); w.w = cvt_pk_bf16(v1[2], v1[3]);
                    *(u32x4*)(rowp + bj * HALF) = w; } }
    }
};
template <int NN> struct MoeOrder {
    const PG8_LAS int* tab; int Mt, G, c;
    __device__ __forceinline__ bool next(int i, Unit& u) const {
        const int L = i * G + c; if (L >= Mt * NN) return false;
        const int mt = L / NN, pnl = L % NN; u.pm = mt; u.pn = __builtin_amdgcn_readfirstlane(tab[mt]) * NN + pnl; return true;
    }
    __device__ __forceinline__ void a_ready(const Unit&) const {}
    __device__ __forceinline__ void done(const Unit&) const {}
};

template <class Epi, class Sched, bool ALIGN_EPI = false, bool SP2 = false>
__device__ __forceinline__ void gemm_phase(PG8_LAS unsigned char* lds, const Gemm g, const Sched& S, const Epi& E) {
    const int tid = opaque_tid(), wid = __builtin_amdgcn_readfirstlane(tid >> 6), lane = tid & 63, wr = wid >> 2, wc = wid & 3, fr = lane & 15, fq = lane >> 4;
    const int K = g.K, nt = K / BK;
    unsigned voffA[2], voffB[2];
#pragma unroll
    for (int i = 0; i < 2; ++i) { int R, C; stage_rc(tid * 16 + i * 8192, R, C); const int Rb = Epi::PERM ? ((R & ~31) + perm32(R & 31)) : R;
        voffA[i] = (unsigned)(R * K + C) * 2u; voffB[i] = (unsigned)(Rb * K + C) * 2u; }
    const size_t kstep = (size_t)(BK * 2);
    const size_t hstep = (size_t)HALF * K * 2;
    const size_t tstep = 2 * hstep;
    const unsigned ldsw = (unsigned)wid * 1024u;
    const int aoff = lds_byte(wr * 64 + fr, fq * 8), boff = lds_byte(wc * 32 + fr, fq * 8);
#define PG8_SA(b, h) (((b) * 2 + (h)) * HTB)
#define PG8_SB(b, h) ((4 + (b) * 2 + (h)) * HTB)
#define PG8_STAGE(bufoff, gbase, voff) do { _Pragma("unroll") for (int _i = 0; _i < 2; ++_i) \
        __builtin_amdgcn_global_load_lds((const unsigned*)((const char*)(gbase) + (voff)[_i]), (PG8_LAS unsigned*)(lds + (bufoff) + ldsw + _i * 8192), 16, 0, 0); } while (0)
#define PG8_LDA(dst, b, h) do { _Pragma("unroll") for (int m = 0; m < 4; ++m) _Pragma("unroll") for (int k = 0; k < 2; ++k) dst[m][k] = *(const PG8_LAS bf16x8*)(lds + PG8_SA(b, h) + aoff + m * 2048 + k * 1024); } while (0)
#define PG8_LDB(dst, b, h) do { _Pragma("unroll") for (int n = 0; n < 2; ++n) _Pragma("unroll") for (int k = 0; k < 2; ++k) dst[n][k] = *(const PG8_LAS bf16x8*)(lds + PG8_SB(b, h) + boff + n * 2048 + k * 1024); } while (0)
#define PG8_MMA(ai, bj, At, Bt) do { __builtin_amdgcn_s_setprio(1); _Pragma("unroll") for (int m = 0; m < 4; ++m) _Pragma("unroll") for (int n = 0; n < 2; ++n) _Pragma("unroll") for (int k = 0; k < 2; ++k) \
        acc[ai][bj][m][n] = __builtin_amdgcn_mfma_f32_16x16x32_bf16(Bt[n][k], At[m][k], acc[ai][bj][m][n], 0, 0, 0); __builtin_amdgcn_s_setprio(0); } while (0)
#define PG8_WAIT_V(n) asm volatile("s_waitcnt vmcnt(" #n ")" ::: "memory")
#define PG8_WAIT_L(n) asm volatile("s_waitcnt lgkmcnt(" #n ")" ::: "memory")
#define PG8_BAR __builtin_amdgcn_s_barrier()
#define PG8_SCHED __builtin_amdgcn_sched_barrier(0)
    Unit cur, nxt; int ui = 0;
    if (!S.next(0, cur)) return;
    f32x4 acc[2][2][4][2];
#pragma unroll
    for (int a = 0; a < 2; ++a)
#pragma unroll
        for (int b = 0; b < 2; ++b)
#pragma unroll
            for (int m = 0; m < 4; ++m)
#pragma unroll
                for (int n = 0; n < 2; ++n) acc[a][b][m][n] = (f32x4){0.f, 0.f, 0.f, 0.f};
    bf16x8 At[4][2], B0[2][2], B1[2][2];
    const char* cA = (const char*)g.A + (size_t)cur.pm * tstep; const char* cB = (const char*)g.Bt + (size_t)cur.pn * tstep;
    S.a_ready(cur);
    if constexpr (SP2) {
        PG8_STAGE(PG8_SB(0, 0), cB, voffB); PG8_STAGE(PG8_SB(0, 1), cB + hstep, voffB); PG8_STAGE(PG8_SA(0, 0), cA, voffA); PG8_STAGE(PG8_SA(0, 1), cA + hstep, voffA);
        if (wr == 1) PG8_BAR;
        PG8_WAIT_V(2); PG8_BAR;
        PG8_STAGE(PG8_SB(1, 0), cB + kstep, voffB); PG8_STAGE(PG8_SA(1, 0), cA + kstep, voffA); PG8_STAGE(PG8_SB(1, 1), cB + hstep + kstep, voffB);
        PG8_WAIT_V(6); PG8_BAR;
    } else {
        PG8_STAGE(PG8_SB(0, 0), cB, voffB); PG8_STAGE(PG8_SA(0, 0), cA, voffA); PG8_STAGE(PG8_SB(0, 1), cB + hstep, voffB); PG8_STAGE(PG8_SA(0, 1), cA + hstep, voffA);
        if (wr == 1) PG8_BAR;
        PG8_WAIT_V(4); PG8_BAR;
        PG8_STAGE(PG8_SB(1, 0), cB + kstep, voffB); PG8_STAGE(PG8_SA(1, 0), cA + kstep, voffA); PG8_STAGE(PG8_SB(1, 1), cB + hstep + kstep, voffB);
        PG8_WAIT_V(6); PG8_BAR;
    }
    for (;;) {
        const bool has_next = S.next(ui + 1, nxt);
        const char* nA = has_next ? (const char*)g.A + (size_t)nxt.pm * tstep : cA; const char* nB = has_next ? (const char*)g.Bt + (size_t)nxt.pn * tstep : cB;
        for (int t = 0; t < nt; t += 2) {
            const bool last = (t == nt - 2);
            const char* a1 = cA + (size_t)(t + 1) * kstep;
            const char* a2 = last ? nA : cA + (size_t)(t + 2) * kstep; const char* b2 = last ? nB : cB + (size_t)(t + 2) * kstep;
            const char* a3 = a2 + kstep; const char* b3 = b2 + kstep;
            if (last && has_next) S.a_ready(nxt);
            if constexpr (SP2) {
            PG8_LDB(B0, 0, 0); PG8_LDB(B1, 0, 1); PG8_SCHED; PG8_LDA(At, 0, 0); PG8_STAGE(PG8_SA(1, 1), a1 + hstep, voffA);
            PG8_WAIT_V(8); PG8_WAIT_L(0); PG8_BAR; PG8_MMA(0, 0, At, B0); PG8_MMA(0, 1, At, B1); PG8_BAR; PG8_SCHED;
            PG8_LDA(At, 0, 1); PG8_STAGE(PG8_SB(0, 0), b2, voffB); PG8_STAGE(PG8_SB(0, 1), b2 + hstep, voffB); PG8_STAGE(PG8_SA(0, 0), a2, voffA);
            PG8_WAIT_V(8); PG8_WAIT_L(0); PG8_BAR; PG8_MMA(1, 0, At, B0); PG8_MMA(1, 1, At, B1); PG8_BAR; PG8_SCHED;
            PG8_LDB(B0, 1, 0); PG8_LDB(B1, 1, 1); PG8_SCHED; PG8_LDA(At, 1, 0); PG8_STAGE(PG8_SA(0, 1), a2 + hstep, voffA);
            PG8_WAIT_V(8); PG8_WAIT_L(0); PG8_BAR; PG8_MMA(0, 0, At, B0); PG8_MMA(0, 1, At, B1); PG8_BAR; PG8_SCHED;
            PG8_LDA(At, 1, 1); PG8_STAGE(PG8_SB(1, 0), b3, voffB); PG8_STAGE(PG8_SB(1, 1), b3 + hstep, voffB); PG8_STAGE(PG8_SA(1, 0), a3, voffA);
            PG8_WAIT_V(8); PG8_WAIT_L(0); PG8_BAR; PG8_MMA(1, 0, At, B0); PG8_MMA(1, 1, At, B1); PG8_BAR; PG8_SCHED;
            } else {
            PG8_LDB(B0, 0, 0); PG8_SCHED; PG8_LDA(At, 0, 0); PG8_STAGE(PG8_SA(1, 1), a1 + hstep, voffA);
            PG8_WAIT_L(8); PG8_BAR; PG8_WAIT_L(0); PG8_MMA(0, 0, At, B0); PG8_BAR; PG8_SCHED;
            PG8_LDB(B1, 0, 1); PG8_STAGE(PG8_SB(0, 0), b2, voffB);
            PG8_BAR; PG8_WAIT_L(0); PG8_MMA(0, 1, At, B1); PG8_BAR;
            PG8_LDA(At, 0, 1); PG8_STAGE(PG8_SA(0, 0), a2, voffA);
            PG8_BAR; PG8_WAIT_L(0); PG8_MMA(1, 0, At, B0); PG8_BAR; PG8_SCHED;
            PG8_STAGE(PG8_SB(0, 1), b2 + hstep, voffB);
            PG8_WAIT_V(6); PG8_BAR; PG8_MMA(1, 1, At, B1); PG8_BAR;
            PG8_LDB(B0, 1, 0); PG8_SCHED; PG8_LDA(At, 1, 0); PG8_STAGE(PG8_SA(0, 1), a2 + hstep, voffA);
            PG8_WAIT_L(8); PG8_BAR; PG8_WAIT_L(0); PG8_MMA(0, 0, At, B0); PG8_BAR; PG8_SCHED;
            PG8_LDB(B1, 1, 1); PG8_STAGE(PG8_SB(1, 0), b3, voffB);
            PG8_BAR; PG8_WAIT_L(0); PG8_MMA(0, 1, At, B1); PG8_BAR;
            PG8_LDA(At, 1, 1); PG8_STAGE(PG8_SA(1, 0), a3, voffA);
            PG8_BAR; PG8_WAIT_L(0); PG8_MMA(1, 0, At, B0); PG8_BAR; PG8_SCHED;
            PG8_STAGE(PG8_SB(1, 1), b3 + hstep, voffB);
            PG8_WAIT_V(6); PG8_BAR; PG8_MMA(1, 1, At, B1); PG8_BAR;
            }
        }
        if constexpr (ALIGN_EPI) { if (wr == 0) PG8_BAR; }
        if constexpr (!Epi::AFTER_DRAIN) { E(acc, cur, wr, wc, fr, fq); S.done(cur); }
        if (!has_next) break;
#pragma unroll
        for (int a = 0; a < 2; ++a)
#pragma unroll
            for (int b = 0; b < 2; ++b)
#pragma unroll
                for (int m = 0; m < 4; ++m)
#pragma unroll
                    for (int n = 0; n < 2; ++n) acc[a][b][m][n] = (f32x4){0.f, 0.f, 0.f, 0.f};
        cur = nxt; cA = nA; cB = nB; ++ui;
        if constexpr (ALIGN_EPI) { if (wr == 1) PG8_BAR; }
    }
    PG8_WAIT_V(0);
    if constexpr (!ALIGN_EPI) { if (wr == 0) PG8_BAR; }
    PG8_BAR;
    if constexpr (Epi::AFTER_DRAIN) { E.fused(acc, cur, wr, wc, fr, fq, lds, wid, lane); S.done(cur); }
#undef PG8_SA
#undef PG8_SB
#undef PG8_STAGE
#undef PG8_LDA
#undef PG8_LDB
#undef PG8_MMA
#undef PG8_WAIT_V
#undef PG8_WAIT_L
#undef PG8_BAR
#undef PG8_SCHED
}
}
namespace attn_body {
using bf16=__hip_bfloat16;
using bf16x8=__attribute__((ext_vector_type(8)))short;
using s16x4=__attribute__((ext_vector_type(4)))short;
using f32x16=__attribute__((ext_vector_type(16)))float;
using u32x4=__attribute__((ext_vector_type(4)))unsigned;
constexpr int SEQ=8192,D=64,NHEAD=6;
constexpr int ZP=2560;
constexpr int OP=1024;
constexpr int NW=8,QBLK=32,QB=QBLK*NW,KVBLK=64,NQB=SEQ/QB;
__device__ __forceinline__ int crow(int r,int hi){return (r&3)+8*(r>>2)+4*hi;}
#define SBAR() __builtin_amdgcn_sched_barrier(0)
__device__ __forceinline__ void cmask(f32x16&p0,f32x16&p1,int jb,int qrel,int hi){
  const float NEG=-INFINITY; int kb=64*jb+4*hi;
  #pragma unroll
  for(int r=0;r<16;++r){int kv=kb+(r&3)+8*(r>>2); if(kv>qrel)p0[r]=NEG; if(kv+32>qrel)p1[r]=NEG;}
}
constexpr int SLOTB=8192;
constexpr int LDS_K=0, LDS_V=2*SLOTB, LDS_WS=4*SLOTB, LDS_FB=LDS_WS+NW*64*4, LDS_OST=LDS_FB+2*64*4, LDS_BYTES=LDS_OST+NW*4096;
constexpr float C2=0.125f*1.4426950408889634f;
constexpr float LOG2E=1.4426950408889634f;
__device__ __forceinline__ void glds16(const void*gsrc,unsigned lds_dst){unsigned keep;
  asm volatile("s_mov_b32 %0, m0\n\ts_mov_b32 m0, %2\n\ts_nop 0\n\tglobal_load_lds_dwordx4 %1, off\n\ts_mov_b32 m0, %0":"=&s"(keep):"v"(gsrc),"s"(lds_dst):"memory");}
__device__ __forceinline__ float max3f(float a,float b,float c){float r;asm("v_max3_f32 %0, %1, %2, %3":"=v"(r):"v"(a),"v"(b),"v"(c));return r;}
__device__ __forceinline__ float max2f(float a,float b){float r;asm("v_max_f32_e32 %0, %1, %2":"=v"(r):"v"(a),"v"(b));return r;}
typedef float f32x2_t __attribute__((ext_vector_type(2))); typedef __bf16 bf16x2_t __attribute__((ext_vector_type(2)));
__device__ __forceinline__ unsigned cvtpk_s(float lo,float hi){f32x2_t v={lo,hi};bf16x2_t b=__builtin_convertvector(v,bf16x2_t);return __builtin_bit_cast(unsigned,b);}
#define WAIT_BAR0() asm volatile("s_waitcnt vmcnt(0) lgkmcnt(0)\n\ts_barrier":::"memory")
__device__ __forceinline__ void qkt(f32x16&p0,f32x16&p1,const char*Kslot,const bf16x8*qr,const f32x16&cinit,int r32,int hi){
  const char*kb=Kslot+hi*1024+r32*16;
  #pragma unroll
  for(int d0=0;d0<4;++d0){
    const bf16x8 b0=*reinterpret_cast<const bf16x8*>(kb+d0*2048);
    const bf16x8 b1=*reinterpret_cast<const bf16x8*>(kb+d0*2048+512);
    if(d0==0){p0=__builtin_amdgcn_mfma_f32_32x32x16_bf16(b0,qr[0],cinit,0,0,0);p1=__builtin_amdgcn_mfma_f32_32x32x16_bf16(b1,qr[0],cinit,0,0,0);}
    else{p0=__builtin_amdgcn_mfma_f32_32x32x16_bf16(b0,qr[d0],p0,0,0,0);p1=__builtin_amdgcn_mfma_f32_32x32x16_bf16(b1,qr[d0],p1,0,0,0);}}
}
__device__ __forceinline__ float rowmax(const f32x16&p0,const f32x16&p1){
  float a=max3f(p0[0],p0[1],p1[0]),b=max3f(p0[2],p0[3],p1[1]);a=max3f(a,p1[2],p1[3]);
  #pragma unroll
  for(int r=4;r<16;r+=4){a=max3f(a,p0[r],p0[r+1]);b=max3f(b,p0[r+2],p0[r+3]);a=max3f(a,p1[r],p1[r+1]);b=max3f(b,p1[r+2],p1[r+3]);}
  const float m=max2f(a,b);
  auto rr=__builtin_amdgcn_permlane32_swap(__float_as_uint(m),__float_as_uint(m),false,false);
  return max2f(__uint_as_float(rr[0]),__uint_as_float(rr[1]));
}
__device__ __forceinline__ void pv(f32x16*o,int vb,bf16x8 pa0,bf16x8 pa1,bf16x8 pa2,bf16x8 pa3){
  #pragma unroll
  for(int d0=0;d0<2;++d0){s16x4 lo[4],hi[4];
    #pragma unroll
    for(int ks=0;ks<4;++ks){
      asm volatile("ds_read_b64_tr_b16 %0,%1 offset:%c2":"=&v"(lo[ks]):"v"(vb),"i"(d0*4096+ks*1024):"memory");
      asm volatile("ds_read_b64_tr_b16 %0,%1 offset:%c2":"=&v"(hi[ks]):"v"(vb),"i"(d0*4096+ks*1024+512):"memory");}
    asm volatile("s_waitcnt lgkmcnt(0)":::"memory");SBAR();
    #define PK(k) (bf16x8){lo[k][0],lo[k][1],lo[k][2],lo[k][3],hi[k][0],hi[k][1],hi[k][2],hi[k][3]}
    o[d0]=__builtin_amdgcn_mfma_f32_32x32x16_bf16(pa0,PK(0),o[d0],0,0,0);
    o[d0]=__builtin_amdgcn_mfma_f32_32x32x16_bf16(pa1,PK(1),o[d0],0,0,0);
    o[d0]=__builtin_amdgcn_mfma_f32_32x32x16_bf16(pa2,PK(2),o[d0],0,0,0);
    o[d0]=__builtin_amdgcn_mfma_f32_32x32x16_bf16(pa3,PK(3),o[d0],0,0,0);
    #undef PK
  }
}
__device__ __forceinline__ void attn_unit(int b,int h,int qb,const bf16*__restrict__ Z,const float*__restrict__ F,bf16*O,char*shm){
  const int tid=opaque_tid(),lane=tid&63,r32=lane&31,hi=lane>>5; const int wid=__builtin_amdgcn_readfirstlane(tid>>6);
  const long rowbase=(long)b*SEQ; const int q0=qb*QB;
  const bf16*Qw=Z+(rowbase+q0+wid*QBLK)*ZP+h*D;
  const bf16*Kh=Z+rowbase*ZP+384+h*D,*Vh=Z+rowbase*ZP+768+h*D;
  const float*Fh=F+(long)(b*NHEAD+h)*SEQ;
  const unsigned lds0=(unsigned)(uintptr_t)shm;
  float*wsf=(float*)(shm+LDS_WS)+wid*64;
  float*fb=(float*)(shm+LDS_FB);
  const bf16*ksrc=Kh+(long)lane*ZP+wid*8;
  const bf16*vsrc=Vh+(long)(16*(wid&3)+(lane>>2))*ZP+(wid>>2)*32+(lane&3)*8;
  const unsigned kdst=lds0+LDS_K+wid*1024, vdst=lds0+LDS_V+wid*1024;
  #define DMA_K(t,slot) glds16(ksrc+(long)(t)*KVBLK*ZP,(unsigned)__builtin_amdgcn_readfirstlane(kdst+(slot)))
  #define DMA_V(t,slot) glds16(vsrc+(long)(t)*KVBLK*ZP,(unsigned)__builtin_amdgcn_readfirstlane(vdst+(slot)))
  const int vb0=(int)(lds0+LDS_V)+((lane>>4)&1)*32+(lane&3)*8+(4*hi+((lane&15)>>2))*64;
  const char*Kbase=shm+LDS_K;
  const int NT=(q0+QB)/KVBLK;
  const float Fref=Fh[q0];
  DMA_K(0,0);DMA_V(0,0);
  if(tid<64)fb[tid]=(Fref-Fh[tid])*LOG2E;
  bf16x8 qr[4];
  #pragma unroll
  for(int d0=0;d0<4;++d0)qr[d0]=*reinterpret_cast<const bf16x8*>(&Qw[(long)r32*ZP+d0*16+hi*8]);
  float mrow=-1e30f,l_reg=0.f;f32x16 o[2];o[0]=f32x16{};o[1]=f32x16{};
  const f32x16 zero16=f32x16{};
  const int qrel=wid*QBLK+r32;
  for(int t=0;t<NT;++t){
    const int slot=(t&1)*SLOTB;
    WAIT_BAR0();
    if(t+1<NT){ DMA_K(t+1,slot^SLOTB); DMA_V(t+1,slot^SLOTB); if(tid<64)fb[((t+1)&1)*64+tid]=(Fref-Fh[(t+1)*KVBLK+tid])*LOG2E; }
    f32x16 p0,p1;
    qkt(p0,p1,Kbase+slot,qr,zero16,r32,hi);
    const float*fbt=fb+(t&1)*64;
    #pragma unroll
    for(int r=0;r<16;++r){ p0[r]+=fbt[crow(r,hi)]; p1[r]+=fbt[32+crow(r,hi)]; }
    { const int jb=t-(NT-4); if(jb>=0)cmask(p0,p1,jb,qrel,hi); }
    const float rm=rowmax(p0,p1);
    const float mnew=fmaxf(mrow,rm);
    const float alpha=__builtin_amdgcn_exp2f(mrow-mnew);
    mrow=mnew;
    float sacc=0.f;
    #pragma unroll
    for(int r=0;r<16;++r){ p0[r]=__builtin_amdgcn_exp2f(p0[r]-mnew); p1[r]=__builtin_amdgcn_exp2f(p1[r]-mnew); sacc+=p0[r]+p1[r]; }
    l_reg=l_reg*alpha+sacc;
    if(hi==0)wsf[r32]=alpha;
    asm volatile("s_waitcnt lgkmcnt(0)":::"memory");
    #pragma unroll
    for(int d_=0;d_<2;++d_){
      #pragma unroll
      for(int r=0;r<16;++r)o[d_][r]*=wsf[crow(r,hi)]; }
    u32x4 pw0,pw1,pw2,pw3;
    pw0=(u32x4){cvtpk_s(p0[0],p0[1]),cvtpk_s(p0[2],p0[3]),cvtpk_s(p0[4],p0[5]),cvtpk_s(p0[6],p0[7])};
    pw1=(u32x4){cvtpk_s(p0[8],p0[9]),cvtpk_s(p0[10],p0[11]),cvtpk_s(p0[12],p0[13]),cvtpk_s(p0[14],p0[15])};
    pw2=(u32x4){cvtpk_s(p1[0],p1[1]),cvtpk_s(p1[2],p1[3]),cvtpk_s(p1[4],p1[5]),cvtpk_s(p1[6],p1[7])};
    pw3=(u32x4){cvtpk_s(p1[8],p1[9]),cvtpk_s(p1[10],p1[11]),cvtpk_s(p1[12],p1[13]),cvtpk_s(p1[14],p1[15])};
    SBAR();
    pv(o,vb0+slot,__builtin_bit_cast(bf16x8,pw0),__builtin_bit_cast(bf16x8,pw1),__builtin_bit_cast(bf16x8,pw2),__builtin_bit_cast(bf16x8,pw3));
  }
  {auto rr=__builtin_amdgcn_permlane32_swap(__float_as_uint(l_reg),__float_as_uint(l_reg),false,false);l_reg=__uint_as_float(rr[0])+__uint_as_float(rr[1]);}
  if(hi==0)wsf[32+r32]=l_reg;asm volatile("s_waitcnt lgkmcnt(0)":::"memory");
  float rli[16];
  #pragma unroll
  for(int r=0;r<16;++r)rli[r]=__builtin_amdgcn_rcpf(wsf[32+crow(r,hi)]);
  bf16*Ow=O+(rowbase+q0+wid*QBLK)*OP+h*D;
  { bf16*stg=(bf16*)(shm+LDS_OST)+wid*2048;
    #pragma unroll
    for(int r=0;r<16;++r){const int orow=crow(r,hi);
      #pragma unroll
      for(int d0=0;d0<2;++d0)stg[orow*64+d0*32+r32]=__float2bfloat16(o[d0][r]*rli[r]);}
    asm volatile("s_waitcnt lgkmcnt(0)":::"memory");
    #pragma unroll
    for(int i=0;i<4;++i){const int row=i*8+(lane>>3),ch=lane&7; const u32x4 v=*(const u32x4*)(stg+row*64+ch*8); *(u32x4*)(Ow+(long)row*OP+ch*8)=v;} }
  asm volatile("s_waitcnt vmcnt(0) lgkmcnt(0)\n\ts_barrier":::"memory");
  #undef DMA_K
  #undef DMA_V
}
constexpr int ATTN_LDS_BYTES=LDS_BYTES;
#undef SBAR
#undef WAIT_BAR0
}

constexpr int NWAVES = 8;
constexpr int BATCH = 2, SEQ = 8192, T = BATCH * SEQ, D = 1024, DEPTH = 4;
constexpr int NZ = 2560, NINP = 2816;
constexpr int NE = 32, TOPK = 4, MROWS = 73728;
constexpr float LN_EPS = 1e-5f, RMS_EPS = 1e-6f, DN_ALPHA = 1.6817928305074290f;
constexpr int FOXH = 6, GLAH = 4, GDK = 48, GDV = 96, GCH = 64, NCHUNK = SEQ / GCH;

constexpr size_t MiB = 1u << 20;
constexpr size_t WS_CTL = 0, CTL_ZERO_BYTES = 1 * MiB;
constexpr size_t WS_MODP = 1 * MiB;
constexpr size_t WS_MOD = 3 * MiB;
constexpr size_t WS_BINP = 3 * MiB + 512 * 1024;
constexpr size_t WS_WRT = 4 * MiB;
constexpr size_t WS_FCUM = 5 * MiB;
constexpr size_t WS_TOKE = 6 * MiB;
constexpr size_t WS_TOKS = 6 * MiB + 512 * 1024;
constexpr size_t WS_TOKG = 7 * MiB;
constexpr size_t WS_TOKR = 7 * MiB + 512 * 1024;
constexpr size_t WS_DEC = 8 * MiB;
constexpr size_t WS_ZF = 10 * MiB;
constexpr size_t WS_WIN = 16 * MiB;
constexpr size_t WS_WOUT = 40 * MiB;
constexpr size_t WS_WGU = 64 * MiB;
constexpr size_t WS_WDN = 576 * MiB;
constexpr size_t WS_X0 = 832 * MiB, WS_X1 = 896 * MiB, WS_Y = 960 * MiB;
constexpr size_t WS_H = 1024 * MiB, WS_H2 = 1056 * MiB, WS_MIX = 1088 * MiB;
constexpr size_t WS_Z = 1120 * MiB;
constexpr size_t WS_KV = 1200 * MiB, WS_ST = 1220 * MiB;
constexpr size_t WS_XROWS = 1280 * MiB, WS_ACT = 1424 * MiB, WS_YROWS = 1568 * MiB;
constexpr size_t WS_END = 1712 * MiB;
constexpr int CW_BAR = 4096;
constexpr int CW_CNT = 16384;

constexpr int RING_OFF = 0, RING_BYTES = 131072;
constexpr int LDSCTL_OFF = RING_BYTES, MISC_OFF = LDSCTL_OFF + 320;
constexpr int LX_TAB = MISC_OFF + 128;
constexpr int LX_PST = LX_TAB + 320 * 4;
constexpr int LX_HIST = LX_PST + 64 * 4;
constexpr int LX_SCR = LX_HIST + 64 * 4;
constexpr int LDS_BYTES = 147456;
static_assert(LX_SCR + 8 * 32 * 4 + 64 <= LDS_BYTES, "LDS map");

#define GAS __attribute__((address_space(1)))
#define LAS __attribute__((address_space(3)))
typedef unsigned short bf16;
typedef unsigned v4u __attribute__((ext_vector_type(4)));
typedef float f32x4 __attribute__((ext_vector_type(4)));
typedef short bf16x8 __attribute__((ext_vector_type(8)));
typedef GAS unsigned gu32;
typedef GAS unsigned long long gu64;
#define RLX_AGENT __ATOMIC_RELAXED, __HIP_MEMORY_SCOPE_AGENT
#define LDS_WAIT() asm volatile("s_waitcnt lgkmcnt(0)" ::: "memory")
#define VM_WAIT() asm volatile("s_waitcnt vmcnt(0)" ::: "memory")
__device__ __forceinline__ unsigned long long rt() { return __builtin_amdgcn_s_memrealtime(); }
__device__ __forceinline__ unsigned f2bf(float f) { unsigned u = __builtin_bit_cast(unsigned, f); return (u + 0x7fffu + ((u >> 16) & 1u)) >> 16; }
__device__ __forceinline__ unsigned pk2(float lo, float hi) { return f2bf(lo) | (f2bf(hi) << 16); }

#define XB_TMO      128
#define XB_XCNT(j)  (256  + 64 * (j))
#define XB_XSUB(j)  (1280 + 64 * (j))
#define XB_XGEN(j)  (2304 + 64 * (j))
#define XB_TOP      3328
#define XB_TOPGEN   3392
#define XCD_BAR_WORDS 3456
#define XB_SPIN_CAP (1u << 18)

__device__ __forceinline__ unsigned xb_ld(unsigned* p)              { return __hip_atomic_load(p, __ATOMIC_RELAXED, __HIP_MEMORY_SCOPE_AGENT); }
__device__ __forceinline__ unsigned xb_add(unsigned* p, unsigned v) { return __hip_atomic_fetch_add(p, v, __ATOMIC_RELAXED, __HIP_MEMORY_SCOPE_AGENT); }
__device__ __forceinline__ unsigned xb_xcc_id() { return (unsigned)__builtin_amdgcn_s_getreg((3 << 11) | 20) & 0xFu; }
#define XB_SPIN(cond, bar) do { unsigned _sp = 0; while (cond) { __builtin_amdgcn_s_sleep(1); \
    if ((++_sp & 255u) == 0u) { if (xb_ld(&(bar)[XB_TMO])) break; if (_sp > XB_SPIN_CAP) { atomicAdd(&(bar)[XB_TMO], 1u); break; } } } } while (0)

struct XcdBarrier {
    unsigned* bar; unsigned x;
    volatile LAS unsigned* st;
};

__device__ __forceinline__ XcdBarrier xcd_barrier_post(unsigned* bar, volatile LAS unsigned* st) {
    XcdBarrier b; b.bar = bar; b.x = xb_xcc_id(); b.st = st;
    if (threadIdx.x == 0) (void)xb_add(&bar[XB_XCNT(b.x)], 1u);
    return b;
}
__device__ __forceinline__ void xcd_barrier_complete(unsigned* bar, unsigned x, unsigned& nloc, unsigned& nx) {
    const unsigned G = gridDim.x * gridDim.y * gridDim.z;
    unsigned sum, cnt, mine, sp = 0u;
    for (;;) {
        sum = 0u; cnt = 0u; mine = 0u;
#pragma unroll
        for (unsigned j = 0; j < 16; ++j) { const unsigned c = xb_ld(&bar[XB_XCNT(j)]); sum += c; cnt += (c > 0u) ? 1u : 0u; mine = (j == x) ? c : mine; }
        if (sum == G) break;
        __builtin_amdgcn_s_sleep(1);
        if ((++sp & 255u) == 0u) { if (xb_ld(&bar[XB_TMO])) break; if (sp > XB_SPIN_CAP) { atomicAdd(&bar[XB_TMO], 1u); break; } }
    }
    nloc = mine > 0u ? mine : 1u; nx = cnt > 0u ? cnt : 1u;
}

__device__ __forceinline__ void xcd_barrier(const XcdBarrier& b) {
    asm volatile("s_waitcnt vmcnt(0)" ::: "memory");
    __syncthreads();
    if (threadIdx.x == 0) {
        unsigned* bar = b.bar;
        __builtin_amdgcn_s_waitcnt(0);
        unsigned nloc = b.st[0], nx = b.st[1];
        if (nloc == 0u) { xcd_barrier_complete(bar, b.x, nloc, nx); b.st[0] = nloc; b.st[1] = nx; }
        const unsigned old = xb_add(&bar[XB_XSUB(b.x)], 1u);
        const unsigned gen = old / nloc;
        if (old + 1u == (gen + 1u) * nloc) {
            __builtin_amdgcn_fence(__ATOMIC_RELEASE, "agent");
            asm volatile("s_waitcnt vmcnt(0)" ::: "memory");
            const unsigned og = xb_add(&bar[XB_TOP], 1u);
            const unsigned tg = og / nx;
            if (og + 1u == (tg + 1u) * nx) xb_add(&bar[XB_TOPGEN], 1u);
            else XB_SPIN(xb_ld(&bar[XB_TOPGEN]) == tg, bar);
            __builtin_amdgcn_fence(__ATOMIC_ACQUIRE, "agent");
            xb_add(&bar[XB_XGEN(b.x)], 1u);
            asm volatile("s_waitcnt vmcnt(0)" ::: "memory");
        } else {
            XB_SPIN(xb_ld(&bar[XB_XGEN(b.x)]) == gen, bar);
            __builtin_amdgcn_fence(__ATOMIC_ACQUIRE, "agent");
            asm volatile("s_waitcnt vmcnt(0)" ::: "memory");
        }
    }
    __syncthreads();
}

struct Frame {
    LAS unsigned char* lds;
    volatile LAS unsigned* MISC;
    gu32* ctl;
    unsigned char* ws;
    int tid, lane, wave;
    int vcu, G;
};
__device__ __forceinline__ float wave_sum(float v) {
#pragma unroll
    for (int o = 1; o < 64; o <<= 1) v += __shfl_xor(v, o);
    return v;
}
__device__ __forceinline__ float bf2f(unsigned v) { return __builtin_bit_cast(float, v << 16); }
__device__ __forceinline__ float log_sigmoidf(float x) { return fminf(x, 0.f) - log1pf(expf(-fabsf(x))); }
__device__ __forceinline__ float siluf(float x) { return x / (1.f + expf(-x)); }
#define WG_SYNC() do { asm volatile("s_waitcnt vmcnt(0) lgkmcnt(0)" ::: "memory"); __syncthreads(); } while (0)

__device__ __forceinline__ void p0_tr_item(const float* W, int Nsrc, bf16* WT, int K, int n0, int k0, int kind, LAS float* scr, int lane) {
    const int n = n0 + (lane & 31);
    int col; float sc = 1.f;
    if (kind == 0) col = n;
    else if (kind == 1) { if (n < 1152) { col = n; if (n < 384) sc = attn_body::C2; } else if (n < 2304) col = n + 6; else if (n < 2560) col = n + 22; else if (n < 2566) col = n - 2560 + 1152; else if (n < 2582) col = n - 2566 + 2310; else col = -1; }
    else { const int pn = n >> 8, rr = n & 255; col = rr < 128 ? 128 * pn + rr : 1024 + 128 * pn + rr - 128; }
#pragma unroll 8
    for (int i = 0; i < 32; ++i) { const int kk = 2 * i + (lane >> 5); scr[kk * 33 + (lane & 31)] = col >= 0 ? W[(size_t)(k0 + kk) * Nsrc + col] * sc : 0.f; }
    LDS_WAIT(); asm volatile("" ::: "memory");
    const int c = lane & 7;
#pragma unroll
    for (int j = 0; j < 4; ++j) { const int nn = (lane >> 3) + 8 * j; const LAS float* s = scr + (8 * c) * 33 + nn;
        v4u o; o.x = pk2(s[0 * 33], s[1 * 33]); o.y = pk2(s[2 * 33], s[3 * 33]); o.z = pk2(s[4 * 33], s[5 * 33]); o.w = pk2(s[6 * 33], s[7 * 33]);
        *(GAS v4u*)(WT + (size_t)(n0 + nn) * K + k0 + 8 * c) = o; }
    LDS_WAIT(); asm volatile("" ::: "memory");
}
__device__ __forceinline__ void ph_convert(Frame& F, const float* const* in) {
    LAS float* scr = (LAS float*)(F.lds + RING_OFF + F.wave * 16384);
    const int gw = F.vcu * NWAVES + F.wave, NGW = F.G * NWAVES, lane = F.lane;
    const float* w_in = in[4]; const float* w_out = in[11]; const float* w_gu = in[16]; const float* w_dn = in[18];
    bf16* WIN = (bf16*)(F.ws + WS_WIN); bf16* WOUT = (bf16*)(F.ws + WS_WOUT); bf16* WGU = (bf16*)(F.ws + WS_WGU); bf16* WDN = (bf16*)(F.ws + WS_WDN);
    constexpr int I_IN = DEPTH * 88 * 16, I_OUT = DEPTH * 32 * 16, I_GU = DEPTH * NE * 64 * 16, I_DN = DEPTH * NE * 32 * 16, I_MOD = DEPTH * 8 * 96, I_WR = DEPTH * 16;
    constexpr int NITEMS = I_MOD + I_IN + I_OUT + I_WR + I_GU + I_DN;
    for (int it = gw; it < NITEMS; it += NGW) {
        int r = it;
        if (r < I_MOD) {
            const int l = r / 768, q = r % 768, kp = q / 96, j = (q % 96) * 64 + lane;
            const float* c = in[1]; const float* wa = in[2] + ((size_t)l * D + kp * 128) * 6144 + j;
            float a0 = 0.f, a1 = 0.f;
            for (int k = 0; k < 128; ++k) { const float w = wa[(size_t)k * 6144]; a0 += siluf(c[kp * 128 + k]) * w; a1 += siluf(c[D + kp * 128 + k]) * w; }
            float* mp = (float*)(F.ws + WS_MODP) + ((size_t)(l * 8 + kp) * 2) * 6144 + j; mp[0] = a0; mp[6144] = a1; continue; } r -= I_MOD;
        if (r < I_IN) { const int l = r / (88 * 16), q = r % (88 * 16); p0_tr_item(w_in + (size_t)l * D * 2582, 2582, WIN + (size_t)l * NINP * D, D, (q / 16) * 32, (q % 16) * 64, 1, scr, lane); continue; } r -= I_IN;
        if (r < I_OUT) { const int l = r / (32 * 16), q = r % (32 * 16); p0_tr_item(w_out + (size_t)l * D * D, D, WOUT + (size_t)l * D * D, D, (q / 16) * 32, (q % 16) * 64, 0, scr, lane); continue; } r -= I_OUT;
        if (r < I_WR) {
            const int l = r / 16, k0 = (r % 16) * 64; const float* wr = in[14] + (size_t)l * D * NE; float* wt = (float*)(F.ws + WS_WRT) + (size_t)l * NE * D;
            for (int i = 0; i < 32; ++i) { const int idx = i * 64 + lane, kk = idx >> 5, e = idx & 31; scr[e * 65 + kk] = wr[(size_t)(k0 + kk) * NE + e]; }
            LDS_WAIT(); asm volatile("" ::: "memory");
            for (int e = 0; e < 32; ++e) wt[(size_t)e * D + k0 + lane] = scr[e * 65 + lane];
            LDS_WAIT(); asm volatile("" ::: "memory");
            continue; } r -= I_WR;
        if (r < I_GU) { const int le = r / (64 * 16), q = r % (64 * 16); p0_tr_item(w_gu + (size_t)le * D * 2048, 2048, WGU + (size_t)le * 2048 * D, D, (q / 16) * 32, (q % 16) * 64, 2, scr, lane); continue; } r -= I_GU;
        { const int le = r / (32 * 16), q = r % (32 * 16); p0_tr_item(w_dn + (size_t)le * D * D, D, WDN + (size_t)le * D * D, D, (q / 16) * 32, (q % 16) * 64, 0, scr, lane); }
    }
    for (int i = (F.vcu * NWAVES + F.wave) * 64 + lane; i < DEPTH * NINP; i += NGW * 64) {
        const int l = i / NINP, n = i % NINP; int col; float sc = 1.f;
        if (n < 1152) { col = n; if (n < 384) sc = attn_body::C2; } else if (n < 2304) col = n + 6; else if (n < 2560) col = n + 22; else if (n < 2566) col = n - 2560 + 1152; else if (n < 2582) col = n - 2566 + 2310; else col = -1;
        ((float*)(F.ws + WS_BINP))[i] = col >= 0 ? in[5][(size_t)l * 2582 + col] * sc : 0.f;
    }
}
__device__ __forceinline__ void ph_modfin(Frame& F, const float* const* in) {
    const float* mp = (const float*)(F.ws + WS_MODP); float* mod = (float*)(F.ws + WS_MOD);
    for (int i = F.vcu * 512 + F.tid; i < DEPTH * 2 * 6144; i += F.G * 512) {
        const int l = i / 12288, q = i % 12288, b = q / 6144, j = q % 6144;
        float s = in[3][(size_t)l * 6144 + j];
#pragma unroll
        for (int p = 0; p < 8; ++p) s += mp[((size_t)(l * 8 + p) * 2 + b) * 6144 + j];
        mod[i] = s;
    }
}
__device__ __forceinline__ void ph_mod0(Frame& F, const float* x) {
    const int gw = F.vcu * NWAVES + F.wave, NGW = F.G * NWAVES, lane = F.lane;
    const float* mod = (const float*)(F.ws + WS_MOD); bf16* H = (bf16*)(F.ws + WS_H);
    for (int m = gw; m < T; m += NGW) {
        const int b = m >> 13; const float* mb = mod + (size_t)b * 6144;
        const GAS f32x4* xr = (const GAS f32x4*)(x + (size_t)m * D) + lane;
        GAS unsigned long long* o8 = (GAS unsigned long long*)(H + (size_t)m * D) + lane;
#pragma unroll
        for (int j = 0; j < 4; ++j) { const f32x4 v = xr[64 * j]; const int c0 = 256 * j + 4 * lane;
            const f32x4 sh = *(const f32x4*)(mb + c0), sc = *(const f32x4*)(mb + 1024 + c0);
            const f32x4 h = v * (sc + 1.0f) + sh;
            o8[64 * j] = (unsigned long long)pk2(h.x, h.y) | ((unsigned long long)pk2(h.z, h.w) << 32); }
    }
}

__device__ __forceinline__ void ph_fcum(Frame& F) {
    const float* ZF = (const float*)(F.ws + WS_ZF); float* FC = (float*)(F.ws + WS_FCUM);
    LAS float* wtot = (LAS float*)(F.lds + LX_SCR);
    for (int u = blockIdx.x; u < BATCH * FOXH; u += F.G) {
        const int b = u / FOXH, h = u % FOXH, t0 = F.tid * 16;
        float v[16]; float run = 0.f;
#pragma unroll
        for (int k = 0; k < 16; ++k) { run += log_sigmoidf(ZF[(size_t)(b * SEQ + t0 + k) * 32 + h]); v[k] = run; }
        float inc = run;
#pragma unroll
        for (int off = 1; off < 64; off <<= 1) { const float y = __shfl_up(inc, off); if (F.lane >= off) inc += y; }
        if (F.lane == 63) wtot[F.wave] = inc;
        WG_SYNC();
        float base = 0.f;
        for (int w = 0; w < F.wave; ++w) base += wtot[w];
        const float excl = base + inc - run;
#pragma unroll
        for (int k = 0; k < 16; ++k) FC[(size_t)u * SEQ + t0 + k] = excl + v[k];
        WG_SYNC();
    }
}
__device__ __forceinline__ void gla_logdecay(Frame& F, LAS float* ga, LAS float* bcum, const float* ZF, const float* wa2, const float* ba, int row0, int h) {
    for (int idx = F.tid; idx < GCH * 16; idx += 512) { const int i = idx >> 4, r = idx & 15; ga[idx] = ZF[(size_t)(row0 + i) * 32 + 6 + r]; }
    WG_SYNC();
    for (int idx = F.tid; idx < GCH * GDK; idx += 512) { const int i = idx / GDK, d = idx % GDK; float s = ba[h * GDK + d];
#pragma unroll
        for (int r = 0; r < 16; ++r) s += ga[i * 16 + r] * wa2[r * 192 + h * GDK + d];
        bcum[i * 49 + d] = log_sigmoidf(s) * (1.0f / 16.0f); }
    WG_SYNC();
    if (F.tid < GDK) { float run = 0.f; for (int i = 0; i < GCH; ++i) { run += bcum[i * 49 + F.tid]; bcum[i * 49 + F.tid] = run; } }
    WG_SYNC();
}
__device__ __forceinline__ void ph_gla1(Frame& F, const float* wa2, const float* ba) {
    const bf16* Z = (const bf16*)(F.ws + WS_Z); const float* ZF = (const float*)(F.ws + WS_ZF);
    float* KV = (float*)(F.ws + WS_KV); float* DEC = (float*)(F.ws + WS_DEC);
    LAS float* L = (LAS float*)(F.lds + RING_OFF);
    LAS float* ga = L, *bcum = L + 1024, *ko = L + 4160, *vv = L + 7296;
    for (int u = blockIdx.x; u < BATCH * GLAH * NCHUNK; u += F.G) {
        const int bh = u / NCHUNK, n = u % NCHUNK, b = bh / GLAH, h = bh % GLAH, row0 = b * SEQ + n * GCH;
        for (int idx = F.tid; idx < GCH * GDK; idx += 512) { const int i = idx / GDK, d = idx % GDK; ko[i * 49 + d] = bf2f(Z[(size_t)(row0 + i) * NZ + 1344 + h * GDK + d]); }
        for (int idx = F.tid; idx < GCH * GDV; idx += 512) { const int i = idx / GDV, v = idx % GDV; vv[idx] = bf2f(Z[(size_t)(row0 + i) * NZ + 1536 + h * GDV + v]); }
        gla_logdecay(F, ga, bcum, ZF, wa2, ba, row0, h);
        for (int idx = F.tid; idx < GCH * GDK; idx += 512) { const int i = idx / GDK, d = idx % GDK; ko[i * 49 + d] *= expf(bcum[63 * 49 + d] - bcum[i * 49 + d]); }
        if (F.tid < GDK) DEC[(size_t)u * GDK + F.tid] = expf(bcum[63 * 49 + F.tid]);
        WG_SYNC();
        for (int idx = F.tid; idx < GDK * GDV; idx += 512) { const int d = idx / GDV, v = idx % GDV; float s = 0.f;
#pragma unroll 8
            for (int i = 0; i < GCH; ++i) s += ko[i * 49 + d] * vv[i * GDV + v];
            KV[(size_t)u * (GDK * GDV) + idx] = s; }
        WG_SYNC();
    }
}
__device__ __forceinline__ void ph_pool(Frame& F, const float* pw, const float* ps) {
    const bf16* Z = (const bf16*)(F.ws + WS_Z); bf16* MIX = (bf16*)(F.ws + WS_MIX);
    LAS float* ub = (LAS float*)(F.lds + RING_OFF); LAS float* pl = ub + 47 * 256;
    for (int u = blockIdx.x; u < T / 32; u += F.G) {
        const int t0 = u * 32, bbase = (t0 >> 13) << 13;
        for (int idx = F.tid; idx < 47 * 256; idx += 512) { const int r = idx >> 8, c = idx & 255, tt = t0 - 15 + r; ub[idx] = tt >= bbase ? bf2f(Z[(size_t)tt * NZ + 2304 + c]) : 0.f; }
        WG_SYNC();
        for (int idx = F.tid; idx < 32 * 256; idx += 512) { const int i = idx >> 8, c = idx & 255, g = c >> 6, w = 2 << g, pos = t0 - bbase + i; const int cnt = pos + 1 < w ? pos + 1 : w;
            float s = 0.f; for (int j = 0; j < w; ++j) s += ub[(15 + i - j) * 256 + c];
            pl[idx] = s / (float)cnt - ub[(15 + i) * 256 + c]; }
        WG_SYNC();
        { const int col = F.tid & 255, half = F.tid >> 8, g = col >> 6, d = col & 63; float acc[16];
#pragma unroll
            for (int k = 0; k < 16; ++k) acc[k] = 0.f;
            for (int c = 0; c < 64; ++c) { const float w = pw[(size_t)(g * 64 + c) * 64 + d];
#pragma unroll
                for (int k = 0; k < 16; ++k) acc[k] += pl[(half * 16 + k) * 256 + g * 64 + c] * w; }
            const float sc = ps[col];
#pragma unroll
            for (int k = 0; k < 16; ++k) MIX[(size_t)(t0 + half * 16 + k) * D + 768 + col] = (bf16)f2bf(acc[k] * sc); }
        WG_SYNC();
    }
}
__device__ __forceinline__ void ph_glascan(Frame& F) {
    const float* KV = (const float*)(F.ws + WS_KV); const float* DEC = (const float*)(F.ws + WS_DEC); float* ST = (float*)(F.ws + WS_ST);
    constexpr int NEL = BATCH * GLAH * GDK * GDV;
    for (int blk = F.G - 1 - (int)blockIdx.x; blk * 512 < NEL; blk += F.G) {
        const int gid = blk * 512 + F.tid; if (gid >= NEL) continue;
        const int bh = gid / (GDK * GDV), e = gid % (GDK * GDV), d = e / GDV; float S = 0.f;
        for (int n = 0; n < NCHUNK; ++n) { const size_t ix = (size_t)bh * NCHUNK + n; ST[ix * (GDK * GDV) + e] = S; S = S * DEC[ix * GDK + d] + KV[ix * (GDK * GDV) + e]; }
    }
}
__device__ __forceinline__ void ph_gla3(Frame& F, const float* wa2, const float* ba, const float* gng) {
    const bf16* Z = (const bf16*)(F.ws + WS_Z); const float* ZF = (const float*)(F.ws + WS_ZF); const float* ST = (const float*)(F.ws + WS_ST); bf16* MIX = (bf16*)(F.ws + WS_MIX);
    LAS float* L = (LAS float*)(F.lds + RING_OFF);
    LAS float* ga = L, *bcum = L + 1024, *qi = L + 4160, *ki = L + 7296, *vv = L + 10432, *at = L + 16576, *st = L + 20736, *oo = L + 25344, *rs = L + 31488;
    for (int u = blockIdx.x; u < BATCH * GLAH * NCHUNK; u += F.G) {
        const int bh = u / NCHUNK, n = u % NCHUNK, b = bh / GLAH, h = bh % GLAH, row0 = b * SEQ + n * GCH;
        for (int idx = F.tid; idx < GCH * GDK; idx += 512) { const int i = idx / GDK, d = idx % GDK;
            qi[i * 49 + d] = bf2f(Z[(size_t)(row0 + i) * NZ + 1152 + h * GDK + d]); ki[i * 49 + d] = bf2f(Z[(size_t)(row0 + i) * NZ + 1344 + h * GDK + d]); }
        for (int idx = F.tid; idx < GCH * GDV; idx += 512) { const int i = idx / GDV, v = idx % GDV; vv[idx] = bf2f(Z[(size_t)(row0 + i) * NZ + 1536 + h * GDV + v]); }
        for (int idx = F.tid; idx < GDK * GDV; idx += 512) st[idx] = ST[(size_t)u * (GDK * GDV) + idx];
        gla_logdecay(F, ga, bcum, ZF, wa2, ba, row0, h);
        for (int idx = F.tid; idx < GCH * GDK; idx += 512) { const int i = idx / GDK, d = idx % GDK; const float bb = bcum[i * 49 + d];
            qi[i * 49 + d] *= 0.14433756729740643f * expf(bb); ki[i * 49 + d] *= expf(-bb); }
        WG_SYNC();
        for (int idx = F.tid; idx < GCH * GCH; idx += 512) { const int i = idx >> 6, j = idx & 63; float s = 0.f;
            if (j <= i) {
#pragma unroll 8
                for (int d = 0; d < GDK; ++d) s += qi[i * 49 + d] * ki[j * 49 + d]; }
            at[i * 65 + j] = s; }
        WG_SYNC();
        for (int idx = F.tid; idx < GCH * GDV; idx += 512) { const int i = idx / GDV, v = idx % GDV; float s = 0.f;
            for (int j = 0; j <= i; ++j) s += at[i * 65 + j] * vv[j * GDV + v];
#pragma unroll 8
            for (int d = 0; d < GDK; ++d) s += qi[i * 49 + d] * st[d * GDV + v];
            oo[idx] = s; }
        WG_SYNC();
        if (F.tid < GCH) { float s = 0.f; for (int v = 0; v < GDV; ++v) { const float x = oo[F.tid * GDV + v]; s += x * x; } rs[F.tid] = 1.0f / sqrtf(s * (1.0f / GDV) + RMS_EPS); }
        WG_SYNC();
        for (int idx = F.tid; idx < GCH * GDV; idx += 512) { const int i = idx / GDV, v = idx % GDV;
            const float gr = bf2f(Z[(size_t)(row0 + i) * NZ + 1920 + h * GDV + v]);
            MIX[(size_t)(row0 + i) * D + 384 + h * GDV + v] = (bf16)f2bf(oo[idx] * rs[i] * gng[h * GDV + v] * siluf(gr)); }
        WG_SYNC();
    }
}
__device__ __forceinline__ void ph_attn(Frame& F, char* lds_generic) {
    const attn_body::bf16* Z = (const attn_body::bf16*)(F.ws + WS_Z); const float* FC = (const float*)(F.ws + WS_FCUM); attn_body::bf16* MIX = (attn_body::bf16*)(F.ws + WS_MIX);
    constexpr int NU = BATCH * FOXH * 32;
    for (int i = 0;; ++i) {
        int pos;
        if ((i & 1) == 0) pos = i * F.G + (int)blockIdx.x; else pos = i * F.G + (F.G - 1 - (int)blockIdx.x);
        if (i * F.G >= NU) break;
        if (pos >= NU) continue;
        const int qb = 31 - pos / (BATCH * FOXH), bh = pos % (BATCH * FOXH);
        attn_body::attn_unit(bh / FOXH, bh % FOXH, qb, Z, FC, MIX, lds_generic);
    }
}

__device__ __forceinline__ void ph_ln1_router(Frame& F, int l, const float* xin, const float* const* in) {
    const int gw = F.vcu * NWAVES + F.wave, NGW = F.G * NWAVES, lane = F.lane;
    const float* mod = (const float*)(F.ws + WS_MOD) + (size_t)l * 2 * 6144;
    const float* Y = (const float*)(F.ws + WS_Y); float* X1 = (float*)(F.ws + WS_X1); bf16* H2 = (bf16*)(F.ws + WS_H2);
    const float* g1 = in[12] + (size_t)l * D; const float* b1 = in[13] + (size_t)l * D; const float* br = in[15] + (size_t)l * NE;
    int* TOKE = (int*)(F.ws + WS_TOKE); int* TOKS = (int*)(F.ws + WS_TOKS); float* TOKG = (float*)(F.ws + WS_TOKG);
    LAS float* wrT = (LAS float*)(F.lds + RING_OFF);
    LAS int* hist = (LAS int*)(F.lds + LX_HIST); LAS int* hbase = hist + 32;
    LAS float* lsc = (LAS float*)(F.lds + LX_SCR) + F.wave * 32;
    { const float* wt = (const float*)(F.ws + WS_WRT) + (size_t)l * NE * D;
      for (int idx = F.tid; idx < NE * D / 4; idx += 512) ((LAS f32x4*)wrT)[idx] = ((const f32x4*)wt)[idx];
      if (F.tid < 32) hist[F.tid] = 0; }
    WG_SYNC();
    for (int m = gw; m < T; m += NGW) {
        const int b = m >> 13; const float* mb = mod + (size_t)b * 6144;
        const GAS f32x4* xr = (const GAS f32x4*)(xin + (size_t)m * D) + lane; const GAS f32x4* yr = (const GAS f32x4*)(Y + (size_t)m * D) + lane;
        f32x4 v[4]; float s = 0.f;
#pragma unroll
        for (int j = 0; j < 4; ++j) { const int c0 = 256 * j + 4 * lane; const f32x4 gt = *(const f32x4*)(mb + 2048 + c0);
            v[j] = xr[64 * j] * DN_ALPHA + (gt + 1.0f) * yr[64 * j]; s += (v[j].x + v[j].y) + (v[j].z + v[j].w); }
        const float mean = wave_sum(s) * (1.f / D); float s2 = 0.f;
#pragma unroll
        for (int j = 0; j < 4; ++j) { v[j] = v[j] - mean; s2 += (v[j].x * v[j].x + v[j].y * v[j].y) + (v[j].z * v[j].z + v[j].w * v[j].w); }
        const float rstd = 1.f / sqrtf(wave_sum(s2) * (1.f / D) + LN_EPS);
        GAS f32x4* x1r = (GAS f32x4*)(X1 + (size_t)m * D) + lane;
        GAS unsigned long long* o8 = (GAS unsigned long long*)(H2 + (size_t)m * D) + lane;
#pragma unroll
        for (int j = 0; j < 4; ++j) { const int c0 = 256 * j + 4 * lane;
            const f32x4 x1 = v[j] * rstd * *(const f32x4*)(g1 + c0) + *(const f32x4*)(b1 + c0);
            x1r[64 * j] = x1;
            const f32x4 h = x1 * (*(const f32x4*)(mb + 4096 + c0) + 1.0f) + *(const f32x4*)(mb + 3072 + c0);
            v[j] = h;
            o8[64 * j] = (unsigned long long)pk2(h.x, h.y) | ((unsigned long long)pk2(h.z, h.w) << 32); }
        float p[32];
#pragma unroll
        for (int e = 0; e < 32; ++e) { float a = 0.f;
#pragma unroll
            for (int j = 0; j < 4; ++j) { const f32x4 w = *(const LAS f32x4*)(wrT + e * D + 256 * j + 4 * lane); a += (v[j].x * w.x + v[j].y * w.y) + (v[j].z * w.z + v[j].w * w.w); }
            p[e] = a; }
#pragma unroll
        for (int i = 0; i < 16; ++i) { const bool up = (lane & 32) != 0; const float keep = up ? p[i + 16] : p[i], send = up ? p[i] : p[i + 16]; p[i] = keep + __shfl_xor(send, 32); }
#pragma unroll
        for (int i = 0; i < 8; ++i) { const bool up = (lane & 16) != 0; const float keep = up ? p[i + 8] : p[i], send = up ? p[i] : p[i + 8]; p[i] = keep + __shfl_xor(send, 16); }
#pragma unroll
        for (int i = 0; i < 4; ++i) { const bool up = (lane & 8) != 0; const float keep = up ? p[i + 4] : p[i], send = up ? p[i] : p[i + 4]; p[i] = keep + __shfl_xor(send, 8); }
#pragma unroll
        for (int i = 0; i < 2; ++i) { const bool up = (lane & 4) != 0; const float keep = up ? p[i + 2] : p[i], send = up ? p[i] : p[i + 2]; p[i] = keep + __shfl_xor(send, 4); }
        { const bool up = (lane & 2) != 0; const float keep = up ? p[1] : p[0], send = up ? p[0] : p[1]; p[0] = keep + __shfl_xor(send, 2); }
        p[0] += __shfl_xor(p[0], 1);
        if ((lane & 1) == 0) lsc[lane >> 1] = p[0] + br[lane >> 1];
        LDS_WAIT(); asm volatile("" ::: "memory");
        float lg[32];
#pragma unroll
        for (int e = 0; e < 32; ++e) lg[e] = lsc[e];
        unsigned used = 0u; int sel[4]; float sv[4];
#pragma unroll
        for (int k = 0; k < 4; ++k) { float best = -INFINITY; int bi = 0;
#pragma unroll
            for (int e = 0; e < 32; ++e) { const bool ok = !((used >> e) & 1u) && lg[e] > best; best = ok ? lg[e] : best; bi = ok ? e : bi; }
            used |= 1u << bi; sel[k] = bi; sv[k] = best; }
        const float e1 = expf(sv[1] - sv[0]), e2 = expf(sv[2] - sv[0]), e3 = expf(sv[3] - sv[0]); const float inv = 1.0f / (1.0f + e1 + e2 + e3);
        if (lane < 4) { const int e = lane == 0 ? sel[0] : lane == 1 ? sel[1] : lane == 2 ? sel[2] : sel[3]; const float gte = (lane == 0 ? 1.0f : lane == 1 ? e1 : lane == 2 ? e2 : e3) * inv;
            const int rank = atomicAdd((int*)(hist + e), 1);
            TOKE[(size_t)m * 4 + lane] = e; TOKS[(size_t)m * 4 + lane] = rank; TOKG[(size_t)m * 4 + lane] = gte; }
        LDS_WAIT(); asm volatile("" ::: "memory");
    }
    WG_SYNC();
    if (F.tid < 32) hbase[F.tid] = (int)__hip_atomic_fetch_add((unsigned*)(F.ctl + CW_CNT + (l * 32 + F.tid) * 64), (unsigned)hist[F.tid], RLX_AGENT);
    WG_SYNC();
    for (int m = gw; m < T; m += NGW) { if (lane < 4) { const size_t q = (size_t)m * 4 + lane; TOKS[q] += hbase[TOKE[q]]; } }
}
__device__ __forceinline__ int moe_tables(Frame& F, int l) {
    LAS int* tab = (LAS int*)(F.lds + LX_TAB); LAS int* pst = (LAS int*)(F.lds + LX_PST);
    if (F.tid == 0) { int run = 0;
#pragma unroll 1
        for (int e = 0; e < NE; ++e) { const int c = (int)__hip_atomic_load((unsigned*)(F.ctl + CW_CNT + (l * 32 + e) * 64), RLX_AGENT); const int nt = (c + 255) >> 8;
            pst[e] = run * 256; for (int k = 0; k < nt; ++k) tab[run + k] = e; run += nt; }
        pst[NE] = run; }
    WG_SYNC();
    return pst[NE];
}
__device__ __forceinline__ void ph_gather(Frame& F, int l) {
    (void)moe_tables(F, l);
    LAS int* pst = (LAS int*)(F.lds + LX_PST);
    const int gw = F.vcu * NWAVES + F.wave, NGW = F.G * NWAVES, lane = F.lane;
    const int* TOKE = (const int*)(F.ws + WS_TOKE); const int* TOKS = (const int*)(F.ws + WS_TOKS); int* TOKR = (int*)(F.ws + WS_TOKR);
    const bf16* H2 = (const bf16*)(F.ws + WS_H2); bf16* XR = (bf16*)(F.ws + WS_XROWS);
    for (int q = gw; q < T * TOPK; q += NGW) {
        const int e = TOKE[q], dest = pst[e] + TOKS[q];
        if (lane == 0) TOKR[q] = dest;
        const GAS v4u* src = (const GAS v4u*)(H2 + (size_t)(q >> 2) * D); GAS v4u* dst = (GAS v4u*)(XR + (size_t)dest * D);
        dst[lane] = src[lane]; dst[64 + lane] = src[64 + lane];
    }
}
__device__ __forceinline__ void ph_ln2(Frame& F, int l, float* xout, const float* const* in) {
    const int gw = F.vcu * NWAVES + F.wave, NGW = F.G * NWAVES, lane = F.lane;
    const float* mod = (const float*)(F.ws + WS_MOD) + (size_t)l * 2 * 6144;
    const float* X1 = (const float*)(F.ws + WS_X1); bf16* H = (bf16*)(F.ws + WS_H); const bf16* YR = (const bf16*)(F.ws + WS_YROWS);
    const float* g2 = in[20] + (size_t)l * D; const float* b2 = in[21] + (size_t)l * D;
    const int* TOKR = (const int*)(F.ws + WS_TOKR); const float* TOKG = (const float*)(F.ws + WS_TOKG);
    for (int m = gw; m < T; m += NGW) {
        const int b = m >> 13; const float* mb = mod + (size_t)b * 6144;
        f32x4 y[4];
#pragma unroll
        for (int j = 0; j < 4; ++j) y[j] = (f32x4){0.f, 0.f, 0.f, 0.f};
#pragma unroll
        for (int k = 0; k < 4; ++k) { const int row = TOKR[(size_t)m * 4 + k]; const float gk = TOKG[(size_t)m * 4 + k];
            const GAS unsigned long long* yr = (const GAS unsigned long long*)(YR + (size_t)row * D) + lane;
#pragma unroll
            for (int j = 0; j < 4; ++j) { const unsigned long long w = yr[64 * j]; const unsigned lo = (unsigned)w, hi = (unsigned)(w >> 32);
                y[j].x += gk * bf2f(lo & 0xffffu); y[j].y += gk * bf2f(lo >> 16); y[j].z += gk * bf2f(hi & 0xffffu); y[j].w += gk * bf2f(hi >> 16); } }
        const GAS f32x4* xr = (const GAS f32x4*)(X1 + (size_t)m * D) + lane;
        f32x4 v[4]; float s = 0.f;
#pragma unroll
        for (int j = 0; j < 4; ++j) { const int c0 = 256 * j + 4 * lane; const f32x4 gt = *(const f32x4*)(mb + 5120 + c0);
            v[j] = xr[64 * j] * DN_ALPHA + (gt + 1.0f) * y[j]; s += (v[j].x + v[j].y) + (v[j].z + v[j].w); }
        const float mean = wave_sum(s) * (1.f / D); float s2 = 0.f;
#pragma unroll
        for (int j = 0; j < 4; ++j) { v[j] = v[j] - mean; s2 += (v[j].x * v[j].x + v[j].y * v[j].y) + (v[j].z * v[j].z + v[j].w * v[j].w); }
        const float rstd = 1.f / sqrtf(wave_sum(s2) * (1.f / D) + LN_EPS);
        GAS f32x4* xo = (GAS f32x4*)(xout + (size_t)m * D) + lane;
        GAS unsigned long long* o8 = (GAS unsigned long long*)(H + (size_t)m * D) + lane;
        const float* mn = mod + 2 * 6144 + (size_t)b * 6144;
#pragma unroll
        for (int j = 0; j < 4; ++j) { const int c0 = 256 * j + 4 * lane;
            const f32x4 x = v[j] * rstd * *(const f32x4*)(g2 + c0) + *(const f32x4*)(b2 + c0);
            xo[64 * j] = x;
            if (l + 1 < DEPTH) { const f32x4 h = x * (*(const f32x4*)(mn + 1024 + c0) + 1.0f) + *(const f32x4*)(mn + c0);
                o8[64 * j] = (unsigned long long)pk2(h.x, h.y) | ((unsigned long long)pk2(h.z, h.w) << 32); } }
    }
}

constexpr int PH_CONV = 0, PH_MODFIN = 1, PH_MOD0 = 2, PH_L0 = 3, PH_PER_LAYER = 10, NPH = PH_L0 + DEPTH * PH_PER_LAYER;
struct Args { const float* in[22]; float* out; unsigned char* ws; int ph_lo, ph_hi; };
__global__ void __launch_bounds__(NWAVES * 64, 2) fwd_kernel(Args args) {
    extern __shared__ __attribute__((aligned(16))) unsigned char lds[];
    Frame F;
    F.lds = (LAS unsigned char*)lds;
    F.MISC = (volatile LAS unsigned*)(F.lds + MISC_OFF);
    F.tid = threadIdx.x; F.lane = F.tid & 63; F.wave = __builtin_amdgcn_readfirstlane(F.tid >> 6);
    F.G = gridDim.x; { const int bx = blockIdx.x; F.vcu = (F.G % 8 == 0) ? (bx % 8) * (F.G / 8) + bx / 8 : bx; }
    F.ws = args.ws; F.ctl = (gu32*)(args.ws + WS_CTL);
    for (int u = F.tid; u < (LDS_BYTES - LDSCTL_OFF) / 4; u += NWAVES * 64) ((LAS unsigned*)(F.lds + LDSCTL_OFF))[u] = 0u;
    __syncthreads();
    XcdBarrier bar; bar.bar = (unsigned*)(F.ctl + CW_BAR); bar.x = 0; bar.st = nullptr;
    if (MK_ONE_LAUNCH) bar = xcd_barrier_post((unsigned*)(F.ctl + CW_BAR), F.MISC + 8);
    const int lo = args.ph_lo, hi = args.ph_hi;
#define IN(k) (lo <= (k) && (k) < hi)
#define REFRESH() do { F.tid = opaque_tid(); F.lane = F.tid & 63; F.wave = __builtin_amdgcn_readfirstlane(F.tid >> 6); } while (0)
#define SEAM(k) do { if (MK_ONE_LAUNCH && IN(k) && IN((k) + 1)) xcd_barrier(bar); } while (0)
    const float* const* in = args.in;

    if (IN(PH_CONV)) {
#ifndef NO_CONV
 REFRESH(); ph_convert(F, in);
#endif
 } SEAM(PH_CONV);
    if (IN(PH_MODFIN)) { REFRESH(); ph_modfin(F, in); } SEAM(PH_MODFIN);
    if (IN(PH_MOD0)) { REFRESH(); ph_mod0(F, in[0]); } SEAM(PH_MOD0);

    for (int l = 0; l < DEPTH; ++l) {
        const int pb = PH_L0 + l * PH_PER_LAYER;
        const float* xin = (l == 0) ? in[0] : (const float*)(F.ws + WS_X0);
        float* xout = (l == DEPTH - 1) ? args.out : (float*)(F.ws + WS_X0);
        if (IN(pb + 0)) {
#ifndef NO_G0
            pg8::Gemm g{(const pg8::bf16_t*)(F.ws + WS_H), (const pg8::bf16_t*)(F.ws + WS_WIN) + (size_t)l * NINP * D, T, NINP, D};
            pg8::StaticOrder S; S.init(T, NINP, F.G, (int)blockIdx.x);
            pg8::EpiZ E{(pg8::bf16_t*)(F.ws + WS_Z), (float*)(F.ws + WS_ZF), (const float*)(F.ws + WS_BINP) + (size_t)l * NINP};
            pg8::gemm_phase<pg8::EpiZ, pg8::StaticOrder, true, true>(F.lds + RING_OFF, g, S, E);
#endif
        } SEAM(pb + 0);
        if (IN(pb + 1)) {
#ifndef NO_PRE
            REFRESH(); ph_fcum(F);
            REFRESH(); ph_gla1(F, in[6] + (size_t)l * 16 * 192, in[7] + (size_t)l * 192);
            REFRESH(); ph_pool(F, in[9] + (size_t)l * 4 * 64 * 64, in[10] + (size_t)l * 256);
#endif
        } SEAM(pb + 1);
        if (IN(pb + 2)) {
#ifndef NO_ATT
            REFRESH(); ph_glascan(F);
            REFRESH(); ph_attn(F, (char*)lds + RING_OFF);
#endif
        } SEAM(pb + 2);
        if (IN(pb + 3)) {
#ifndef NO_GLA3
 REFRESH(); ph_gla3(F, in[6] + (size_t)l * 16 * 192, in[7] + (size_t)l * 192, in[8] + (size_t)l * 384);
#endif
 } SEAM(pb + 3);
        if (IN(pb + 4)) {
#ifndef NO_G4
            pg8::Gemm g{(const pg8::bf16_t*)(F.ws + WS_MIX), (const pg8::bf16_t*)(F.ws + WS_WOUT) + (size_t)l * D * D, T, D, D};
            pg8::StaticOrder S; S.init(T, D, F.G, (int)blockIdx.x);
            pg8::EpiF32 E{(float*)(F.ws + WS_Y), D, nullptr};
            pg8::gemm_phase<pg8::EpiF32, pg8::StaticOrder, true, true>(F.lds + RING_OFF, g, S, E);
#endif
        } SEAM(pb + 4);
        if (IN(pb + 5)) {
#ifndef NO_LN1
 REFRESH(); ph_ln1_router(F, l, xin, in);
#endif
 } SEAM(pb + 5);
        if (IN(pb + 6)) {
#ifndef NO_GATHER
 REFRESH(); ph_gather(F, l);
#endif
 } SEAM(pb + 6);
        if (IN(pb + 7)) {
#ifndef NO_G7
            REFRESH(); const int Mt = __builtin_amdgcn_readfirstlane(moe_tables(F, l));
            pg8::Gemm g{(const pg8::bf16_t*)(F.ws + WS_XROWS), (const pg8::bf16_t*)(F.ws + WS_WGU) + (size_t)l * NE * 2048 * D, MROWS, 2048, D};
            pg8::MoeOrder<8> S{(const LAS int*)(F.lds + LX_TAB), Mt, F.G, (int)blockIdx.x};
            pg8::EpiSwiglu E{(pg8::bf16_t*)(F.ws + WS_ACT), in[17] + (size_t)l * NE * 2048};
            pg8::gemm_phase<pg8::EpiSwiglu, pg8::MoeOrder<8>, true, true>(F.lds + RING_OFF, g, S, E);
#endif
        } SEAM(pb + 7);
        if (IN(pb + 8)) {
#ifndef NO_G8
            REFRESH(); const int Mt = __builtin_amdgcn_readfirstlane(moe_tables(F, l));
            pg8::Gemm g{(const pg8::bf16_t*)(F.ws + WS_ACT), (const pg8::bf16_t*)(F.ws + WS_WDN) + (size_t)l * NE * D * D, MROWS, D, D};
            pg8::MoeOrder<4> S{(const LAS int*)(F.lds + LX_TAB), Mt, F.G, (int)blockIdx.x};
            pg8::EpiDown E{(pg8::bf16_t*)(F.ws + WS_YROWS), in[19] + (size_t)l * NE * D};
            pg8::gemm_phase<pg8::EpiDown, pg8::MoeOrder<4>, true, true>(F.lds + RING_OFF, g, S, E);
#endif
        } SEAM(pb + 8);
        if (IN(pb + 9)) {
#ifndef NO_LN2
 REFRESH(); ph_ln2(F, l, xout, in);
#endif
 } SEAM(pb + 9);
    }
#undef IN
#undef SEAM
}

extern "C" void kernel_launch(void* const* d_in, const int* in_sizes, int n_in, void* d_out, int out_size, void* d_ws, size_t ws_size, hipStream_t stream) {
    static int grid = 0;
    if (grid == 0) {
        if (n_in != 22 || in_sizes[0] != T * D || out_size != T * D || ws_size < WS_END) { fprintf(stderr, "kernel_launch: unexpected shapes (n_in %d, in0 %d, out %d, ws %zu)\n", n_in, n_in > 0 ? in_sizes[0] : -1, out_size, ws_size); grid = -1; return; }
        int dev = 0, cus = 0, per_cu = 0;
        if (hipGetDevice(&dev) != hipSuccess || hipDeviceGetAttribute(&cus, hipDeviceAttributeMultiprocessorCount, dev) != hipSuccess) { grid = -1; return; }
        if (hipFuncSetAttribute((const void*)fwd_kernel, hipFuncAttributeMaxDynamicSharedMemorySize, LDS_BYTES) != hipSuccess) { fprintf(stderr, "kernel_launch: hipFuncSetAttribute failed\n"); grid = -1; return; }
        if (hipOccupancyMaxActiveBlocksPerMultiprocessor(&per_cu, (const void*)fwd_kernel, NWAVES * 64, LDS_BYTES) != hipSuccess || per_cu < 1) fprintf(stderr, "kernel_launch: occupancy query reports %d\n", per_cu);
        (void)hipGetLastError();
        grid = cus;
    }
    if (grid < 0) return;
    if (hipMemsetAsync((char*)d_ws + WS_CTL, 0, CTL_ZERO_BYTES, stream) != hipSuccess) return;
    Args a{};
    for (int i = 0; i < 22; ++i) a.in[i] = (const float*)d_in[i];
    a.out = (float*)d_out; a.ws = (unsigned char*)d_ws;
#if MK_ONE_LAUNCH
    a.ph_lo = 0; a.ph_hi = NPH;
    hipLaunchKernelGGL(fwd_kernel, dim3(grid), dim3(NWAVES * 64), LDS_BYTES, stream, a);
#else
    for (int p = 0; p < NPH; ++p) { a.ph_lo = p; a.ph_hi = p + 1; hipLaunchKernelGGL(fwd_kernel, dim3(grid), dim3(NWAVES * 64), LDS_BYTES, stream, a); }
#endif
}
```

```cpp
#include <hip/hip_runtime.h>
#include <hip/hip_bf16.h>
#include <cstdio>
#include <cstdint>
#include <cmath>
__device__ __forceinline__ int opaque_tid() { int t = threadIdx.x; asm volatile("" : "+v"(t)); return t; }
#ifndef MK_ONE_LAUNCH
#define MK_ONE_LAUNCH 1
#endif
namespace pg8 {
#define PG8_LAS __attribute__((address_space(3)))
typedef unsigned short bf16_t;
typedef short bf16x8 __attribute__((ext_vector_type(8)));
typedef float f32x4 __attribute__((ext_vector_type(4)));
typedef unsigned u32x4 __attribute__((ext_vector_type(4)));
typedef unsigned u32x2 __attribute__((ext_vector_type(2)));
typedef int i32x8 __attribute__((ext_vector_type(8)));
typedef int i32x4 __attribute__((ext_vector_type(4)));
__device__ __forceinline__ unsigned pk4_fp8(float a, float b, float c, float d) { int r = __builtin_amdgcn_cvt_pk_fp8_f32(a, b, 0, false); r = __builtin_amdgcn_cvt_pk_fp8_f32(c, d, r, true); return (unsigned)r; }
constexpr int TOKL_OFF = 137664;
constexpr int BM = 256, BK = 64, HALF = 128, HTB = HALF * BK * 2  , STAGE_BYTES = 8 * HTB, NXCD = 8, WGM = 8;

__host__ __device__ __forceinline__ int lds_byte(int r, int c) { const int st = (r >> 4) * 2 + (c >> 5), rr = r & 15, cc = c & 31, ob = rr * 64 + cc * 2; return st * 1024 + (ob ^ (((ob >> 9) & 1) << 5)); }
__host__ __device__ __forceinline__ void stage_rc(int b, int& R, int& C) { const int st = b / 1024, sb = b % 1024, swz = sb ^ (((sb >> 9) & 1) << 5); R = (st >> 1) * 16 + swz / 64; C = (st & 1) * 32 + (swz % 64) / 2; }
__host__ __device__ __forceinline__ int perm32(int rho) { const int n = rho >> 4, i = rho & 15; return 8 * (i >> 2) + 4 * n + (i & 3); }

struct Unit { int pm, pn; };
struct Gemm { const bf16_t* A; const bf16_t* Bt; int M, N, K; };

struct StaticOrder {
    int nM, nN, nwg, G, c;
    __host__ __device__ void init(int M, int N, int G_, int c_) { nM = M / BM; nN = N / BM; nwg = nM * nN; G = G_; c = c_; }
    __host__ __device__ bool next(int i, Unit& u) const {
        const long L = (long)i * G + c; if (L >= nwg) return false;
        int wgid = (int)L; { const int q = nwg / NXCD, r = nwg % NXCD, xcd = wgid % NXCD, off = wgid / NXCD; wgid = (xcd < r ? xcd * (q + 1) : r * (q + 1) + (xcd - r) * q) + off; }
        const int nig = WGM * nN, gid = wgid / nig, fm = gid * WGM, gsz = (nM - fm) < WGM ? (nM - fm) : WGM;
        u.pm = fm + ((wgid % nig) % gsz); u.pn = (wgid % nig) / gsz; return true;
    }
    __device__ __forceinline__ unsigned peek(const Unit&) const { return 0u; }
    __device__ __forceinline__ void a_ready(const Unit&, unsigned = 0u) const {}
    __device__ __forceinline__ void done(const Unit&) const {}
    __device__ __forceinline__ void publish(int) const {}
};

__device__ __forceinline__ unsigned cvt_pk_bf16(float lo, float hi) { unsigned r; asm volatile("v_cvt_pk_bf16_f32 %0, %1, %2" : "=v"(r) : "v"(lo), "v"(hi)); return r; }
typedef float f32x2 __attribute__((ext_vector_type(2)));
struct EpiF32 {
    static constexpr bool PERM = false, AFTER_DRAIN = false;
    float* C; int ldc; const float* bias;
    __device__ __forceinline__ void operator()(const f32x4 (&acc)[2][2][4][2], const Unit& u, int wr, int wc, int fr, int fq) const {
        const int row0 = u.pm * BM + wr * 64 + fr, col0 = u.pn * BM + wc * 32 + 4 * fq;
        f32x4 bv[2][2];
#pragma unroll
        for (int bj = 0; bj < 2; ++bj)
#pragma unroll
            for (int n = 0; n < 2; ++n) bv[bj][n] = bias ? *(const f32x4*)(bias + col0 + bj * HALF + n * 16) : (f32x4){0.f, 0.f, 0.f, 0.f};
#pragma unroll
        for (int ai = 0; ai < 2; ++ai)
#pragma unroll
            for (int m = 0; m < 4; ++m) { float* rowp = C + (size_t)(row0 + ai * HALF + m * 16) * ldc + col0;
#pragma unroll
                for (int bj = 0; bj < 2; ++bj)
#pragma unroll
                    for (int n = 0; n < 2; ++n) *(f32x4*)(rowp + bj * HALF + n * 16) = acc[ai][bj][m][n] + bv[bj][n]; }
    }
};
struct EpiY {
    static constexpr bool PERM = true, AFTER_DRAIN = false;
    bf16_t* Y;
    __device__ __forceinline__ void operator()(const f32x4 (&acc)[2][2][4][2], const Unit& u, int wr, int wc, int fr, int fq) const {
        const int row0 = u.pm * BM + wr * 64 + fr, col0 = u.pn * BM + wc * 32 + 8 * fq;
#pragma unroll
        for (int ai = 0; ai < 2; ++ai)
#pragma unroll
            for (int m = 0; m < 4; ++m) { bf16_t* rowp = Y + (size_t)(row0 + ai * HALF + m * 16) * 1024 + col0;
#pragma unroll
                for (int bj = 0; bj < 2; ++bj) { const f32x4 v0 = acc[ai][bj][m][0], v1 = acc[ai][bj][m][1];
                    u32x4 w; w.x = cvt_pk_bf16(v0[0], v0[1]); w.y = cvt_pk_bf16(v0[2], v0[3]); w.z = cvt_pk_bf16(v1[0], v1[1]); w.w = cvt_pk_bf16(v1[2], v1[3]);
                    *(u32x4*)(rowp + bj * HALF) = w; } }
    }
};
struct EpiZ {
    static constexpr bool PERM = true, AFTER_DRAIN = false;
    bf16_t* Z; float* ZF; const float* bias; float* LF;
    __device__ __forceinline__ void operator()(const f32x4 (&acc)[2][2][4][2], const Unit& u, int wr, int wc, int fr, int fq) const {
        const int row0 = u.pm * BM + wr * 64 + fr;
        if (u.pn < 10) {
            const int col0 = u.pn * BM + wc * 32 + 8 * fq;
            f32x4 bv[2][2];
#pragma unroll
            for (int bj = 0; bj < 2; ++bj)
#pragma unroll
                for (int n = 0; n < 2; ++n) bv[bj][n] = *(const f32x4*)(bias + col0 + bj * HALF + 4 * n);
#pragma unroll
            for (int ai = 0; ai < 2; ++ai)
#pragma unroll
                for (int m = 0; m < 4; ++m) { bf16_t* rowp = Z + (size_t)(row0 + ai * HALF + m * 16) * 2560 + col0;
#pragma unroll
                    for (int bj = 0; bj < 2; ++bj) { const f32x4 v0 = acc[ai][bj][m][0] + bv[bj][0], v1 = acc[ai][bj][m][1] + bv[bj][1];
                        u32x4 w; w.x = cvt_pk_bf16(v0[0], v0[1]); w.y = cvt_pk_bf16(v0[2], v0[3]); w.z = cvt_pk_bf16(v1[0], v1[1]); w.w = cvt_pk_bf16(v1[2], v1[3]);
                        *(u32x4*)(rowp + bj * HALF) = w; } }
        } else if (wc == 0) {
            const f32x4 b0 = *(const f32x4*)(bias + 2560 + 8 * fq), b1 = *(const f32x4*)(bias + 2560 + 8 * fq + 4);
#pragma unroll
            for (int ai = 0; ai < 2; ++ai)
#pragma unroll
                for (int m = 0; m < 4; ++m) { const int row = row0 + ai * HALF + m * 16; float* rp = ZF + (size_t)row * 32 + 8 * fq;
                    const f32x4 z0 = acc[ai][0][m][0] + b0, z1 = acc[ai][0][m][1] + b1;
                    *(f32x4*)rp = z0; *(f32x4*)(rp + 4) = z1;
                    if (fq == 0) { float* lf = LF + (size_t)(row >> 13) * 6 * 8192 + (row & 8191);
#define EPIZ_LS(x) (fminf((x), 0.f) - __logf(1.0f + __expf(-fabsf(x))))
                        lf[0] = EPIZ_LS(z0[0]); lf[8192] = EPIZ_LS(z0[1]); lf[2 * 8192] = EPIZ_LS(z0[2]); lf[3 * 8192] = EPIZ_LS(z0[3]); lf[4 * 8192] = EPIZ_LS(z1[0]); lf[5 * 8192] = EPIZ_LS(z1[1]);
#undef EPIZ_LS
                    } }
        }
    }
};
struct EpiSwiglu {
    static constexpr bool PERM = true, AFTER_DRAIN = false;
    unsigned char* ACT; const float* bgu;
    __device__ __forceinline__ void operator()(const f32x4 (&acc)[2][2][4][2], const Unit& u, int wr, int wc, int fr, int fq) const {
        const int e = u.pn >> 3, pnl = u.pn & 7;
        const int row0 = u.pm * BM + wr * 64 + fr, col0 = pnl * 128 + wc * 32 + 8 * fq;
        const float* bg = bgu + (size_t)e * 2048 + col0;
        const f32x4 bg0 = *(const f32x4*)bg, bg1 = *(const f32x4*)(bg + 4), bl0 = *(const f32x4*)(bg + 1024), bl1 = *(const f32x4*)(bg + 1028);
#pragma unroll
        for (int ai = 0; ai < 2; ++ai)
#pragma unroll
            for (int m = 0; m < 4; ++m) {
                f32x4 g0 = acc[ai][0][m][0] + bg0, g1 = acc[ai][0][m][1] + bg1, l0 = acc[ai][1][m][0] + bl0, l1 = acc[ai][1][m][1] + bl1;
                float o[8];
#pragma unroll
                for (int j = 0; j < 4; ++j) {
                    float g = fminf(g0[j], 7.0f), l = fminf(fmaxf(l0[j], -7.0f), 7.0f);
                    o[j] = g * __builtin_amdgcn_rcpf(1.0f + __expf(-1.702f * g)) * (l + 1.0f);
                    g = fminf(g1[j], 7.0f); l = fminf(fmaxf(l1[j], -7.0f), 7.0f);
                    o[4 + j] = g * __builtin_amdgcn_rcpf(1.0f + __expf(-1.702f * g)) * (l + 1.0f);
                }
                u32x2 w; w.x = pk4_fp8(o[0], o[1], o[2], o[3]); w.y = pk4_fp8(o[4], o[5], o[6], o[7]);
                __hip_atomic_store((unsigned long long*)(ACT + (size_t)(row0 + ai * HALF + m * 16) * 1024 + col0), (unsigned long long)w.x | ((unsigned long long)w.y << 32), __ATOMIC_RELAXED, __HIP_MEMORY_SCOPE_AGENT);
            }
    }
};
struct EpiDown {
    static constexpr bool PERM = true, AFTER_DRAIN = false;
    bf16_t* Y; const float* bdn;
    __device__ __forceinline__ void operator()(const f32x4 (&acc)[2][2][4][2], const Unit& u, int wr, int wc, int fr, int fq) const {
        const int e = u.pn >> 2, pnl = u.pn & 3;
        const int row0 = u.pm * BM + wr * 64 + fr, col0 = pnl * BM + wc * 32 + 8 * fq;
        f32x4 bv[2][2];
#pragma unroll
        for (int bj = 0; bj < 2; ++bj)
#pragma unroll
            for (int n = 0; n < 2; ++n) bv[bj][n] = *(const f32x4*)(bdn + (size_t)e * 1024 + col0 + bj * HALF + 4 * n);
#pragma unroll
        for (int ai = 0; ai < 2; ++ai)
#pragma unroll
            for (int m = 0; m < 4; ++m) { bf16_t* rowp = Y + (size_t)(row0 + ai * HALF + m * 16) * 1024 + col0;
#pragma unroll
                for (int bj = 0; bj < 2; ++bj) { const f32x4 v0 = acc[ai][bj][m][0] + bv[bj][0], v1 = acc[ai][bj][m][1] + bv[bj][1];
                    u32x4 w; w.x = cvt_pk_bf16(v0[0], v0[1]); w.y = cvt_pk_bf16(v0[2], v0[3]); w.z = cvt_pk_bf16(v1[0], v1[1]); w.w = cvt_pk_bf16(v1[2], v1[3]);
                    *(u32x4*)(rowp + bj * HALF) = w; } }
    }
};
template <int NN, int ROLE = 0> struct MoeOrder {
    const PG8_LAS int* tab; const PG8_LAS int* pst; const PG8_LAS int* cnt; const int* list; int Mt, G, c;
    unsigned* ready;
    int xs;
    __device__ __forceinline__ bool next(int i, Unit& u) const {
        int mt, pnl;
        if (G == 256) { const int x = ((c & 7) - xs) & 7, j = c >> 3, NG = (Mt + 7) >> 3, st = i * 8 + x;
            if (st >= NG * (NN / 4)) return false;
            const int gm = (NN == 8) ? (st >> 1) : st, nh = (NN == 8) ? (st & 1) : 0; mt = gm * 8 + (j & 7); if (mt >= Mt) mt = Mt - 1; pnl = nh * 4 + (j >> 3); }
        else { const int L = i * G + c; if (L >= Mt * NN) return false; mt = L / NN; pnl = L % NN; }
        u.pm = mt; u.pn = __builtin_amdgcn_readfirstlane(tab[mt]) * NN + pnl; return true;
    }
    __device__ __forceinline__ const int* row_addr(const Unit& u, int r) const {
        const int e = __builtin_amdgcn_readfirstlane(tab[u.pm]); const int idx = u.pm * 256 - pst[e] + r, c = cnt[e];
        return list + e * 16384 + (idx < c ? idx : c - 1);
    }
    __device__ __forceinline__ int row_token(const Unit& u, int r) const {
        const int e = __builtin_amdgcn_readfirstlane(tab[u.pm]); const int idx = u.pm * 256 - pst[e] + r, c = cnt[e];
        return list[e * 16384 + (idx < c ? idx : c - 1)];
    }
    __device__ __forceinline__ unsigned peek(const Unit& u) const {
        if constexpr (ROLE == 2) { if (threadIdx.x < 64) return __hip_atomic_load(ready + 64 * u.pm, __ATOMIC_RELAXED, __HIP_MEMORY_SCOPE_AGENT); }
        return 0u;
    }
    __device__ __forceinline__ void a_ready(const Unit& u, unsigned early = 0u) const {
        if constexpr (ROLE == 2) {
            if (threadIdx.x < 64) { unsigned sp = 0;
                if ((unsigned)__builtin_amdgcn_readfirstlane(early) < 64u)
                while ((unsigned)__builtin_amdgcn_readfirstlane(__hip_atomic_load(ready + 64 * u.pm, __ATOMIC_RELAXED, __HIP_MEMORY_SCOPE_AGENT)) < 64u) { __builtin_amdgcn_s_sleep(2); if (++sp > (1u << 22)) break; }
                __builtin_amdgcn_fence(__ATOMIC_ACQUIRE, "agent");
                asm volatile("s_waitcnt vmcnt(0)" ::: "memory"); }
            asm volatile("" ::: "memory"); __builtin_amdgcn_s_barrier(); asm volatile("" ::: "memory");
        }
    }
    __device__ __forceinline__ void done(const Unit&) const {}
    __device__ __forceinline__ void publish(int pm) const {
        if constexpr (ROLE == 1) { if (pm >= 0 && (threadIdx.x & 63) == 0) __hip_atomic_fetch_add(ready + 64 * pm, 1u, __ATOMIC_RELAXED, __HIP_MEMORY_SCOPE_AGENT); }
    }
};

template <class Epi, class Sched, bool ALIGN_EPI = false, bool GATHER = false, bool FP8 = false>
__device__ __forceinline__ void gemm_phase(PG8_LAS unsigned char* lds, const Gemm g, const Sched& S, const Epi& E, const int scale_w = 0x7f7f7f7f) {
    const int tid = opaque_tid(), wid = __builtin_amdgcn_readfirstlane(tid >> 6), lane = tid & 63, wr = wid >> 2, wc = wid & 3, fr = lane & 15, fq = lane >> 4;
    const int K = g.K, nt = K / BK;
    const unsigned kstep = (unsigned)(BK * 2);
    const unsigned hstep = (unsigned)HALF * K * 2;
    const unsigned tstep = 2 * hstep;
    const __amdgpu_buffer_rsrc_t rsrcA = __builtin_amdgcn_make_buffer_rsrc((void*)g.A, 0, 0x7fffffff, 0x00020000), rsrcB = __builtin_amdgcn_make_buffer_rsrc((void*)g.Bt, 0, 0x7fffffff, 0x00020000);
    unsigned vAc[2][2], vAn[2][2], voffB[2]; int sR[2], sC[2];
#pragma unroll
    for (int i = 0; i < 2; ++i) { int R, C; stage_rc(tid * 16 + i * 8192, R, C); const int Rb = Epi::PERM ? ((R & ~31) + perm32(R & 31)) : R; sR[i] = R; sC[i] = C;
        voffB[i] = (unsigned)(Rb * K + C) * 2u;
#pragma unroll
        for (int h = 0; h < 2; ++h) { vAc[h][i] = (unsigned)(R * K + C) * 2u + (unsigned)(h * hstep); vAn[h][i] = vAc[h][i]; } }
    const unsigned ldsw = (unsigned)wid * 1024u;
    const int aoff = lds_byte(wr * 64 + fr, fq * 8), boff = lds_byte(wc * 32 + fr, fq * 8);
#define PG8_SA(b, h) (((b) * 2 + (h)) * HTB)
#define PG8_SB(b, h) ((4 + (b) * 2 + (h)) * HTB)
#define PG8_STAGE_(bufoff, rsrc, soff, voff) do { _Pragma("unroll") for (int _i = 0; _i < 2; ++_i) \
        __builtin_amdgcn_raw_ptr_buffer_load_lds(rsrc, (PG8_LAS void*)(lds + (bufoff) + ldsw + _i * 8192), 16, (voff)[_i], (soff), 0, 0); } while (0)
#define PG8_STAGE_A(bufoff, soff, voff) PG8_STAGE_(bufoff, rsrcA, soff, voff)
#define PG8_STAGE_B(bufoff, soff, voff) PG8_STAGE_(bufoff, rsrcB, soff, voff)
#define PG8_LDA(dst, b, h) do { _Pragma("unroll") for (int m = 0; m < 4; ++m) _Pragma("unroll") for (int k = 0; k < 2; ++k) dst[m][k] = *(const PG8_LAS bf16x8*)(lds + PG8_SA(b, h) + aoff + m * 2048 + k * 1024); } while (0)
#define PG8_LDB(dst, b, h) do { _Pragma("unroll") for (int n = 0; n < 2; ++n) _Pragma("unroll") for (int k = 0; k < 2; ++k) dst[n][k] = *(const PG8_LAS bf16x8*)(lds + PG8_SB(b, h) + boff + n * 2048 + k * 1024); } while (0)
#define PG8_CAT(x) __builtin_shufflevector(__builtin_bit_cast(i32x4, (x)[0]), __builtin_bit_cast(i32x4, (x)[1]), 0, 1, 2, 3, 4, 5, 6, 7)
#define PG8_MMA(ai, bj, At, Bt) do { __builtin_amdgcn_s_setprio(1); _Pragma("unroll") for (int m = 0; m < 4; ++m) _Pragma("unroll") for (int n = 0; n < 2; ++n) { \
        if constexpr (FP8) { asm("v_mfma_scale_f32_16x16x128_f8f6f4 %0, %1, %2, %0, %3, %4 op_sel_hi:[0,0,0]" : "+v"(acc[ai][bj][m][n]) : "v"(PG8_CAT(Bt[n])), "v"(PG8_CAT(At[m])), "v"(scale_w), "v"(sone)); } \
        else { _Pragma("unroll") for (int k = 0; k < 2; ++k) acc[ai][bj][m][n] = __builtin_amdgcn_mfma_f32_16x16x32_bf16(Bt[n][k], At[m][k], acc[ai][bj][m][n], 0, 0, 0); } } __builtin_amdgcn_s_setprio(0); } while (0)
#define PG8_WAIT_V(n) asm volatile("s_waitcnt vmcnt(" #n ")" ::: "memory")
#define PG8_WAIT_L(n) asm volatile("s_waitcnt lgkmcnt(" #n ")" ::: "memory")
#define PG8_BAR __builtin_amdgcn_s_barrier()
#define PG8_SCHED __builtin_amdgcn_sched_barrier(0)
    unsigned early = 0u;
    const PG8_LAS int* tokl = (const PG8_LAS int*)(lds + TOKL_OFF) + wid * 256;
    const unsigned tokl_base = (unsigned)__builtin_amdgcn_readfirstlane((int)(unsigned)(uintptr_t)(lds + TOKL_OFF) + wid * 1024);
    Unit cur, nxt; int ui = 0; int pend = -1;
    if (!S.next(0, cur)) return;
    const int sone = 0x7f7f7f7f;
    f32x4 acc[2][2][4][2];
#pragma unroll
    for (int a = 0; a < 2; ++a)
#pragma unroll
        for (int b = 0; b < 2; ++b)
#pragma unroll
            for (int m = 0; m < 4; ++m)
#pragma unroll
                for (int n = 0; n < 2; ++n) acc[a][b][m][n] = (f32x4){0.f, 0.f, 0.f, 0.f};
    bf16x8 At[4][2], B0[2][2], B1[2][2];
    unsigned cA = GATHER ? 0u : (unsigned)cur.pm * tstep, cB = (unsigned)cur.pn * tstep;
    if constexpr (GATHER) {
#pragma unroll
        for (int h = 0; h < 2; ++h)
#pragma unroll
            for (int i = 0; i < 2; ++i) { vAc[h][i] = (unsigned)(S.row_token(cur, h * HALF + sR[i]) * K + sC[i]) * 2u; vAn[h][i] = vAc[h][i]; }
    }
    S.a_ready(cur);
    PG8_STAGE_B(PG8_SB(0, 0), cB, voffB); PG8_STAGE_B(PG8_SB(0, 1), cB + hstep, voffB); PG8_STAGE_A(PG8_SA(0, 0), cA, vAc[0]); PG8_STAGE_A(PG8_SA(0, 1), cA, vAc[1]);
    if (wr == 1) PG8_BAR;
    PG8_WAIT_V(2); PG8_BAR;
    PG8_STAGE_B(PG8_SB(1, 0), cB + kstep, voffB); PG8_STAGE_A(PG8_SA(1, 0), cA + kstep, vAc[0]); PG8_STAGE_B(PG8_SB(1, 1), cB + hstep + kstep, voffB);
    PG8_WAIT_V(6); PG8_BAR;
    for (;;) {
        const bool has_next = S.next(ui + 1, nxt);
        const unsigned nA = (has_next && !GATHER) ? (unsigned)nxt.pm * tstep : cA, nB = has_next ? (unsigned)nxt.pn * tstep : cB;
#pragma unroll 1
        for (int t = 0; t < nt; t += 2) {
            const bool last = (t == nt - 2);
            if (t == nt - 4 && has_next) early = S.peek(nxt);
            if constexpr (GATHER) {
                if (t == nt - 4 && has_next) {
#pragma unroll
                    for (int h = 0; h < 2; ++h)
#pragma unroll
                        for (int i = 0; i < 2; ++i) { const int* ga_ = S.row_addr(nxt, h * HALF + sR[i]); unsigned keep_;
                            asm volatile("s_mov_b32 %0, m0\n\ts_mov_b32 m0, %2\n\ts_nop 0\n\tglobal_load_lds_dword %1, off\n\ts_mov_b32 m0, %0" : "=&s"(keep_) : "v"(ga_), "s"(tokl_base + (unsigned)((h * 2 + i) * 256)) : "memory"); } }
                if (last && has_next) {
#pragma unroll
                    for (int h = 0; h < 2; ++h)
#pragma unroll
                        for (int i = 0; i < 2; ++i) vAn[h][i] = (unsigned)(tokl[(h * 2 + i) * 64 + lane] * K + sC[i]) * 2u; } }
            unsigned vA2[2][2];
#pragma unroll
            for (int h = 0; h < 2; ++h)
#pragma unroll
                for (int i = 0; i < 2; ++i) vA2[h][i] = last ? vAn[h][i] : vAc[h][i];
            const unsigned a1 = cA + (unsigned)(t + 1) * kstep;
            const unsigned a2 = last ? nA : cA + (unsigned)(t + 2) * kstep, b2 = last ? nB : cB + (unsigned)(t + 2) * kstep;
            const unsigned a3 = a2 + kstep, b3 = b2 + kstep;
            if (last && has_next) S.a_ready(nxt, early);
            PG8_LDB(B0, 0, 0); PG8_LDB(B1, 0, 1); PG8_SCHED; PG8_LDA(At, 0, 0); PG8_STAGE_A(PG8_SA(1, 1), a1, vAc[1]);
            PG8_WAIT_V(8); PG8_WAIT_L(0); PG8_BAR; PG8_MMA(0, 0, At, B0); PG8_MMA(0, 1, At, B1); PG8_BAR; PG8_SCHED;
            PG8_LDA(At, 0, 1); PG8_STAGE_B(PG8_SB(0, 0), b2, voffB); PG8_STAGE_B(PG8_SB(0, 1), b2 + hstep, voffB); PG8_STAGE_A(PG8_SA(0, 0), a2, vA2[0]);
            PG8_WAIT_V(8); PG8_WAIT_L(0); PG8_BAR; PG8_MMA(1, 0, At, B0); PG8_MMA(1, 1, At, B1); PG8_BAR; PG8_SCHED;
            PG8_LDB(B0, 1, 0); PG8_LDB(B1, 1, 1); PG8_SCHED; PG8_LDA(At, 1, 0); PG8_STAGE_A(PG8_SA(0, 1), a2, vA2[1]);
            PG8_WAIT_V(8); PG8_WAIT_L(0); PG8_BAR; PG8_MMA(0, 0, At, B0); PG8_MMA(0, 1, At, B1); PG8_BAR; PG8_SCHED;
            PG8_LDA(At, 1, 1); PG8_STAGE_B(PG8_SB(1, 0), b3, voffB); PG8_STAGE_B(PG8_SB(1, 1), b3 + hstep, voffB); PG8_STAGE_A(PG8_SA(1, 0), a3, vA2[0]);
            PG8_WAIT_V(8); PG8_WAIT_L(0); PG8_BAR; PG8_MMA(1, 0, At, B0); PG8_MMA(1, 1, At, B1); PG8_BAR; PG8_SCHED;
        }
        if constexpr (ALIGN_EPI) { if (wr == 0) PG8_BAR; }
        if constexpr (FP8) asm volatile("s_nop 15\n\ts_nop 15" ::: "memory");
        S.publish(pend); E(acc, cur, wr, wc, fr, fq); S.done(cur); pend = cur.pm;
        if (!has_next) break;
#pragma unroll
        for (int a = 0; a < 2; ++a)
#pragma unroll
            for (int b = 0; b < 2; ++b)
#pragma unroll
                for (int m = 0; m < 4; ++m)
#pragma unroll
                    for (int n = 0; n < 2; ++n) acc[a][b][m][n] = (f32x4){0.f, 0.f, 0.f, 0.f};
        cur = nxt; cA = nA; cB = nB; ++ui;
#pragma unroll
        for (int h = 0; h < 2; ++h)
#pragma unroll
            for (int i = 0; i < 2; ++i) vAc[h][i] = vAn[h][i];
        if constexpr (ALIGN_EPI) { if (wr == 1) PG8_BAR; }
    }
    PG8_WAIT_V(0);
    S.publish(pend);
    if constexpr (!ALIGN_EPI) { if (wr == 0) PG8_BAR; }
    PG8_BAR;
#undef PG8_SA
#undef PG8_SB
#undef PG8_STAGE_
#undef PG8_STAGE_A
#undef PG8_STAGE_B
#undef PG8_LDA
#undef PG8_LDB
#undef PG8_MMA
#undef PG8_CAT
#undef PG8_WAIT_V
#undef PG8_WAIT_L
#undef PG8_BAR
#undef PG8_SCHED
}
}
namespace attn_body {
using bf16=__hip_bfloat16;
using bf16x8=__attribute__((ext_vector_type(8)))short;
using s16x4=__attribute__((ext_vector_type(4)))short;
using f32x16=__attribute__((ext_vector_type(16)))float;
using u32x4=__attribute__((ext_vector_type(4)))unsigned;
constexpr int SEQ=8192,D=64,NHEAD=6;
constexpr int ZP=2560;
constexpr int OP=1024;
constexpr int NW=8,QBLK=32,QB=QBLK*NW,KVBLK=64,NQB=SEQ/QB;
__device__ __forceinline__ int crow(int r,int hi){return (r&3)+8*(r>>2)+4*hi;}
#define SBAR() __builtin_amdgcn_sched_barrier(0)
__device__ __forceinline__ void cmask(f32x16&p0,f32x16&p1,int jb,int qrel,int hi){
  const float NEG=-INFINITY; int kb=64*jb+4*hi;
  #pragma unroll
  for(int r=0;r<16;++r){int kv=kb+(r&3)+8*(r>>2); if(kv>qrel)p0[r]=NEG; if(kv+32>qrel)p1[r]=NEG;}
}
constexpr int NSLOT=3, SLOTB=8192;
constexpr int LDS_K=0, LDS_V=NSLOT*SLOTB, LDS_WS=2*NSLOT*SLOTB, LDS_OST=LDS_WS+NW*64*4, LDS_FS=LDS_OST+NW*4096, LDS_BYTES=LDS_FS+NW*512;
constexpr float C2=0.125f*1.4426950408889634f;
constexpr float LOG2E=1.4426950408889634f;
__device__ __forceinline__ void glds16(const void*gsrc,unsigned lds_dst){unsigned keep;
  asm volatile("s_mov_b32 %0, m0\n\ts_mov_b32 m0, %2\n\ts_nop 0\n\tglobal_load_lds_dwordx4 %1, off\n\ts_mov_b32 m0, %0":"=&s"(keep):"v"(gsrc),"s"(lds_dst):"memory");}
__device__ __forceinline__ void glds4(const void*gsrc,unsigned lds_dst){unsigned keep;
  asm volatile("s_mov_b32 %0, m0\n\ts_mov_b32 m0, %2\n\ts_nop 0\n\tglobal_load_lds_dword %1, off\n\ts_mov_b32 m0, %0":"=&s"(keep):"v"(gsrc),"s"(lds_dst):"memory");}
__device__ __forceinline__ float max3f(float a,float b,float c){float r;asm("v_max3_f32 %0, %1, %2, %3":"=v"(r):"v"(a),"v"(b),"v"(c));return r;}
__device__ __forceinline__ float max2f(float a,float b){float r;asm("v_max_f32_e32 %0, %1, %2":"=v"(r):"v"(a),"v"(b));return r;}
__device__ __forceinline__ float fadd_s(float a,float b){float r;asm("v_add_f32_e32 %0, %1, %2":"=v"(r):"v"(a),"v"(b));return r;}
__device__ __forceinline__ float fsub_s(float a,float b){float r;asm("v_sub_f32_e32 %0, %1, %2":"=v"(r):"v"(a),"v"(b));return r;}
typedef float f32x2_t __attribute__((ext_vector_type(2))); typedef __bf16 bf16x2_t __attribute__((ext_vector_type(2)));
__device__ __forceinline__ unsigned cvtpk_s(float lo,float hi){f32x2_t v={lo,hi};bf16x2_t b=__builtin_convertvector(v,bf16x2_t);return __builtin_bit_cast(unsigned,b);}
#define WAIT_BAR(N) asm volatile("s_waitcnt vmcnt(" #N ") lgkmcnt(0)\n\ts_barrier":::"memory")
typedef __attribute__((address_space(3))) const char* lds_cptr;
typedef short v4i16_t __attribute__((ext_vector_type(4)));
__device__ __forceinline__ void kload8(bf16x8*kf,lds_cptr kp){
  kf[0]=*(const __attribute__((address_space(3))) bf16x8*)(kp);      kf[1]=*(const __attribute__((address_space(3))) bf16x8*)(kp+512);
  kf[2]=*(const __attribute__((address_space(3))) bf16x8*)(kp+2048); kf[3]=*(const __attribute__((address_space(3))) bf16x8*)(kp+2560);
  kf[4]=*(const __attribute__((address_space(3))) bf16x8*)(kp+4096); kf[5]=*(const __attribute__((address_space(3))) bf16x8*)(kp+4608);
  kf[6]=*(const __attribute__((address_space(3))) bf16x8*)(kp+6144); kf[7]=*(const __attribute__((address_space(3))) bf16x8*)(kp+6656);
}
__device__ __forceinline__ void kload2(bf16x8*kf,lds_cptr kp,int j){ kf[2*j]=*(const __attribute__((address_space(3))) bf16x8*)(kp+j*2048); kf[2*j+1]=*(const __attribute__((address_space(3))) bf16x8*)(kp+j*2048+512); }
__device__ __forceinline__ s16x4 vtr(lds_cptr p){ return __builtin_bit_cast(s16x4,__builtin_amdgcn_ds_read_tr16_b64_v4i16((__attribute__((address_space(3))) v4i16_t*)p)); }
__device__ __forceinline__ float rowmax(const f32x16&p0,const f32x16&p1){
  float a=max3f(p0[0],p0[1],p1[0]),b=max3f(p0[2],p0[3],p1[1]);a=max3f(a,p1[2],p1[3]);
  #pragma unroll
  for(int r=4;r<16;r+=4){a=max3f(a,p0[r],p0[r+1]);b=max3f(b,p0[r+2],p0[r+3]);a=max3f(a,p1[r],p1[r+1]);b=max3f(b,p1[r+2],p1[r+3]);}
  const float m=max2f(a,b);
  auto rr=__builtin_amdgcn_permlane32_swap(__float_as_uint(m),__float_as_uint(m),false,false);
  return max2f(__uint_as_float(rr[0]),__uint_as_float(rr[1]));
}
__device__ __forceinline__ void pv(f32x16*o,int vb,bf16x8 pa0,bf16x8 pa1,bf16x8 pa2,bf16x8 pa3){
  #pragma unroll
  for(int d0=0;d0<2;++d0){s16x4 lo[4],hi[4];
    #pragma unroll
    for(int ks=0;ks<4;++ks){
      asm volatile("ds_read_b64_tr_b16 %0,%1 offset:%c2":"=&v"(lo[ks]):"v"(vb),"i"(d0*4096+ks*1024):"memory");
      asm volatile("ds_read_b64_tr_b16 %0,%1 offset:%c2":"=&v"(hi[ks]):"v"(vb),"i"(d0*4096+ks*1024+512):"memory");}
    asm volatile("s_waitcnt lgkmcnt(0)":::"memory");SBAR();
    #define PK(k) (bf16x8){lo[k][0],lo[k][1],lo[k][2],lo[k][3],hi[k][0],hi[k][1],hi[k][2],hi[k][3]}
    o[d0]=__builtin_amdgcn_mfma_f32_32x32x16_bf16(pa0,PK(0),o[d0],0,0,0);
    o[d0]=__builtin_amdgcn_mfma_f32_32x32x16_bf16(pa1,PK(1),o[d0],0,0,0);
    o[d0]=__builtin_amdgcn_mfma_f32_32x32x16_bf16(pa2,PK(2),o[d0],0,0,0);
    o[d0]=__builtin_amdgcn_mfma_f32_32x32x16_bf16(pa3,PK(3),o[d0],0,0,0);
    #undef PK
  }
}
#define AUGM(a,b) __builtin_amdgcn_mfma_f32_32x32x2f32((a),(b),(f32x16){},0,0,0)
template<int THRL> __device__ __forceinline__ void attn_unit(int b,int h,int qb,const bf16*__restrict__ Z,const float*__restrict__ F,const float qkb,bf16*O,char*shm){
  const int tid=opaque_tid(),lane=tid&63,r32=lane&31,hi=lane>>5; const int wid=__builtin_amdgcn_readfirstlane(tid>>6);
  const long rowbase=(long)b*SEQ; const int q0=qb*QB;
  const bf16*Qw=Z+(rowbase+q0+wid*QBLK)*ZP+h*D;
  const float*Fh0=F+(long)(b*NHEAD+h)*SEQ; const float Fref=Fh0[q0]; const int NTfull=(q0+QB)/KVBLK;
  int t0;
  { const float th=-(150.0f+2.0f*qkb+4.0f); int cntt=0;
    #pragma unroll
    for(int k=0;k<2;++k){ const int tt=lane+1+64*k; const bool inr=(tt<=NTfull-4); const bool c=inr&&((Fref-Fh0[(inr?tt:1)*KVBLK-1])*LOG2E<=th); cntt+=__builtin_popcountll(__ballot(c)); }
    t0=(cntt<NTfull-4?cntt:NTfull-4)&~1; t0=__builtin_amdgcn_readfirstlane(t0); }
  const bf16*Kh=Z+(rowbase+(long)t0*KVBLK)*ZP+384+h*D,*Vh=Z+(rowbase+(long)t0*KVBLK)*ZP+768+h*D;
  const float*Fh=Fh0+t0*KVBLK;
  const unsigned lds0=(unsigned)(uintptr_t)shm;
  float*wsf=(float*)(shm+LDS_WS)+wid*64;
  const bf16*ksrc=Kh+(long)lane*ZP+wid*8;
  const bf16*vsrc=Vh+(long)(16*(wid&3)+(lane>>2))*ZP+(wid>>2)*32+(lane&3)*8;
  const unsigned kdst=lds0+LDS_K+wid*1024, vdst=lds0+LDS_V+wid*1024;
  #define DMA_K(t,slot) glds16(ksrc+(long)(t)*KVBLK*ZP,(unsigned)__builtin_amdgcn_readfirstlane(kdst+(slot)))
  #define DMA_V(t,slot) glds16(vsrc+(long)(t)*KVBLK*ZP,(unsigned)__builtin_amdgcn_readfirstlane(vdst+(slot)))
  const int vb0=(int)(lds0+LDS_V)+((lane>>4)&1)*32+(lane&3)*8+(4*hi+((lane&15)>>2))*64;
  bf16x8 kf[8];
  const lds_cptr shm3=(lds_cptr)shm; const lds_cptr kp0=shm3+LDS_K+hi*1024+r32*16; const lds_cptr vp0=shm3+LDS_V+((lane>>4)&1)*32+(lane&3)*8+(4*hi+((lane&15)>>2))*64;
  const int NT=NTfull-t0;
  const float*Fl=Fh+r32;
  const float*fsl=(const float*)(shm+LDS_FS)+wid*128;
  const unsigned fdst=lds0+LDS_FS+wid*512;
  #define FLOAD(tau) glds4(Fh+(long)(tau)*KVBLK+lane,(unsigned)__builtin_amdgcn_readfirstlane(fdst+((tau)&1)*256))
  const float f0a=Fl[0],f0b=Fl[32],f1a=Fl[64],f1b=Fl[96],f0l=Fh[63],f1l=Fh[127];
  DMA_K(0,0);DMA_V(0,0);DMA_K(1,SLOTB);
  bf16x8 qr[4];
  #pragma unroll
  for(int d0=0;d0<4;++d0)qr[d0]=*reinterpret_cast<const bf16x8*>(&Qw[(long)r32*ZP+d0*16+hi*8]);
  float mhat=0.f,l_reg=0.f;f32x16 o[2];o[0]=f32x16{};o[1]=f32x16{};
  const int qrel=wid*QBLK+r32;
  float a0=hi?1.0f:(Fref-f0a)*LOG2E, a1=hi?1.0f:(Fref-f0b)*LOG2E, bq=hi?0.0f:1.0f;
  float fs=1.0f;
  float Flast=f0l;
  #define CMASK(P0,P1,t) do{int jb_=(t)-(NT-4); if(jb_>=0)cmask(P0,P1,jb_,qrel,hi);}while(0)
  bool resc=false;
  #define START(P0,P1) do{ const float rm=rowmax(P0,P1); resc=false; \
    { const float dl=rm; mhat=fadd_s(mhat,dl); \
      _Pragma("unroll") for(int r=0;r<16;++r){P0[r]=fsub_s(P0[r],dl);P1[r]=fsub_s(P1[r],dl);} } \
    _Pragma("unroll") for(int r=0;r<16;++r)P0[r]=__builtin_amdgcn_exp2f(P0[r]); }while(0)
  #define RESC() do{ if(resc){ asm volatile("s_waitcnt lgkmcnt(0)":::"memory"); \
      _Pragma("unroll") for(int d_=0;d_<2;++d_) _Pragma("unroll") for(int r=0;r<16;++r)o[d_][r]*=wsf[crow(r,hi)]; } \
      _Pragma("unroll") for(int d_=0;d_<2;++d_) _Pragma("unroll") for(int r=0;r<16;++r)o[d_][r]*=fs; }while(0)
  #define NEXTB(tn,FA,FB,FL) do{ const float fl_=(FL); \
      const float db_=((tn)<NT-4)?(Flast-fl_)*LOG2E:0.f; Flast=fl_; mhat+=db_; fs=__builtin_amdgcn_exp2f(-db_); bq=hi?-mhat:1.0f; \
      a0=hi?1.0f:(Fref-(FA))*LOG2E; a1=hi?1.0f:(Fref-(FB))*LOG2E; }while(0)
  #define NEXTL(tn) do{ const float*fp_=fsl+((tn)&1)*64; NEXTB(tn,fp_[r32],fp_[32+r32],fp_[63]); }while(0)
  f32x16 pA0,pA1,pB0,pB1;
  int sl_prev=0,sl_cur=0,sl_next=SLOTB;
  #define ROT() do{sl_prev=sl_cur;sl_cur=sl_next;sl_next=(sl_next==(NSLOT-1)*SLOTB)?0:sl_next+SLOTB;}while(0)
  DMA_K(2,2*SLOTB);
  WAIT_BAR(3);
  { const char*kb=(shm+LDS_K)+hi*1024+r32*16;
    pA0=AUGM(a0,bq); pA1=AUGM(a1,bq);
    #pragma unroll
    for(int d0=0;d0<4;++d0){ const bf16x8 b0=*reinterpret_cast<const bf16x8*>(kb+d0*2048); const bf16x8 b1=*reinterpret_cast<const bf16x8*>(kb+d0*2048+512);
      pA0=__builtin_amdgcn_mfma_f32_32x32x16_bf16(b0,qr[d0],pA0,0,0,0); pA1=__builtin_amdgcn_mfma_f32_32x32x16_bf16(b1,qr[d0],pA1,0,0,0); } }
  asm volatile("s_nop 15\n\ts_nop 7":"+v"(pA0),"+v"(pA1));CMASK(pA0,pA1,0);
  START(pA0,pA1);
  _Pragma("unroll") for(int r=0;r<16;++r)pA1[r]=__builtin_amdgcn_exp2f(pA1[r]);
  WAIT_BAR(0);
  DMA_K(3,0);DMA_V(1,SLOTB);
  FLOAD(2);
  ROT();
  kload8(kf,kp0+sl_cur);
  NEXTB(1,f1a,f1b,f1l);
  WAIT_BAR(3);
  s16x4 vlo[8],vhi[8]; u32x4 pw0,pw1,pw2,pw3;
  #define PKW(P,B) cvtpk_s(P[B],P[B+1])
  #define PAF(k) __builtin_bit_cast(bf16x8,pw##k)
  #define VFR(i) (bf16x8){vlo[i][0],vlo[i][1],vlo[i][2],vlo[i][3],vhi[i][0],vhi[i][1],vhi[i][2],vhi[i][3]}
  #define PIN(x) asm volatile("":"+v"(x))
  #define MX3(a,b,c) __builtin_fmaxf(__builtin_fmaxf((a),(b)),(c))
  #define GAPA(MF,A0,A1,A2,A3,W0,W1,PW) do{ MF; sacc+=A0; sacc+=A1; sacc+=A2; sacc+=A3; PIN(sacc); W0; W1; PIN(PW); SBAR(); }while(0)
  #define EX(v) __builtin_amdgcn_exp2f(v)
  #define GAPB(MF,X,B) do{ MF; X[B]=EX(X[B]); X[B+1]=EX(X[B+1]); X[B+2]=EX(X[B+2]); X[B+3]=EX(X[B+3]); PIN(X); SBAR(); }while(0)
  #define VRD(i) do{ vlo[i]=vtr(vp_+(((i)>>2)*4096+((i)&3)*1024)); vhi[i]=vtr(vp_+(((i)>>2)*4096+((i)&3)*1024+512)); }while(0)
  #define KRD(G,j) do{ if(G){ kload2(kf,kp0+sl_next,j); SBAR(); } }while(0)
  #define STEP(C0,C1,P0,P1,t,GK,GV,GL,GF) do{ SBAR(); \
    const lds_cptr vp_=vp0+sl_prev; \
    C0=AUGM(a0,bq); C1=AUGM(a1,bq); SBAR(); \
    VRD(0); SBAR(); float sacc=(P0[0]+P0[1]); \
    GAPA(C0=__builtin_amdgcn_mfma_f32_32x32x16_bf16(kf[0],qr[0],C0,0,0,0), P0[2],P0[3],P0[4],P0[5],     pw0[0]=PKW(P0,0), pw0[1]=PKW(P0,2), pw0); \
    VRD(4); SBAR(); GAPA(C1=__builtin_amdgcn_mfma_f32_32x32x16_bf16(kf[1],qr[0],C1,0,0,0), P0[6],P0[7],P0[8],P0[9],     pw0[2]=PKW(P0,4), pw0[3]=PKW(P0,6), pw0); \
    VRD(1); SBAR(); GAPA(C0=__builtin_amdgcn_mfma_f32_32x32x16_bf16(kf[2],qr[1],C0,0,0,0),   P0[10],P0[11],P0[12],P0[13], pw1[0]=PKW(P0,8), pw1[1]=PKW(P0,10), pw1); \
    VRD(5); SBAR(); GAPA(C1=__builtin_amdgcn_mfma_f32_32x32x16_bf16(kf[3],qr[1],C1,0,0,0),   P0[14],P0[15],P1[0],P1[1],   pw1[2]=PKW(P0,12),pw1[3]=PKW(P0,14), pw1); \
    VRD(2); SBAR(); GAPA(C0=__builtin_amdgcn_mfma_f32_32x32x16_bf16(kf[4],qr[2],C0,0,0,0),   P1[2],P1[3],P1[4],P1[5],     pw2[0]=PKW(P1,0), pw2[1]=PKW(P1,2), pw2); \
    VRD(6); SBAR(); GAPA(C1=__builtin_amdgcn_mfma_f32_32x32x16_bf16(kf[5],qr[2],C1,0,0,0),   P1[6],P1[7],P1[8],P1[9],     pw2[2]=PKW(P1,4), pw2[3]=PKW(P1,6), pw2); \
    VRD(3); SBAR(); GAPA(C0=__builtin_amdgcn_mfma_f32_32x32x16_bf16(kf[6],qr[3],C0,0,0,0),   P1[10],P1[11],P1[12],P1[13], pw3[0]=PKW(P1,8), pw3[1]=PKW(P1,10), pw3); \
    VRD(7); SBAR(); GAPA(C1=__builtin_amdgcn_mfma_f32_32x32x16_bf16(kf[7],qr[3],C1,0,0,0),   P1[14],P1[15],0.f,0.f,       pw3[2]=PKW(P1,12),pw3[3]=PKW(P1,14), pw3); \
    l_reg+=sacc; l_reg*=fs; \
    if(GK){DMA_K((t)+3,sl_cur);} if(GV){DMA_V((t)+1,sl_next);} if(GF){FLOAD((t)+2);} \
    CMASK(C0,C1,t); \
    { float a=MX3(C0[0],C0[1],C1[0]),b=MX3(C0[2],C0[3],C1[1]); a=MX3(a,C1[2],C1[3]); \
      _Pragma("unroll") for(int r=4;r<16;r+=4){a=MX3(a,C0[r],C0[r+1]);b=MX3(b,C0[r+2],C0[r+3]);a=MX3(a,C1[r],C1[r+1]);b=MX3(b,C1[r+2],C1[r+3]);} \
      float rm=__builtin_fmaxf(a,b); { auto rr=__builtin_amdgcn_permlane32_swap(__float_as_uint(rm),__float_as_uint(rm),false,false); rm=__builtin_fmaxf(__uint_as_float(rr[0]),__uint_as_float(rr[1])); } \
      resc=false; \
      if(__builtin_expect(__any(rm>(float)THRL),0)){ const float dl=__builtin_fmaxf(rm,0.f); mhat+=dl; \
        _Pragma("unroll") for(int r=0;r<16;++r){C0[r]-=dl;C1[r]-=dl;} \
        bq=hi?-mhat:1.0f; \
        const float f=__builtin_amdgcn_exp2f(-dl); l_reg*=f; if(hi==0)wsf[r32]=f; resc=true; } } \
    SBAR(); \
    GAPB(o[0]=__builtin_amdgcn_mfma_f32_32x32x16_bf16(PAF(0),VFR(0),o[0],0,0,0), C0,0); \
    GAPB(o[1]=__builtin_amdgcn_mfma_f32_32x32x16_bf16(PAF(0),VFR(4),o[1],0,0,0), C0,4); \
    KRD(GL,0); GAPB(o[0]=__builtin_amdgcn_mfma_f32_32x32x16_bf16(PAF(1),VFR(1),o[0],0,0,0), C0,8); \
    KRD(GL,1); GAPB(o[1]=__builtin_amdgcn_mfma_f32_32x32x16_bf16(PAF(1),VFR(5),o[1],0,0,0), C0,12); \
    KRD(GL,2); GAPB(o[0]=__builtin_amdgcn_mfma_f32_32x32x16_bf16(PAF(2),VFR(2),o[0],0,0,0), C1,0); \
    KRD(GL,3); GAPB(o[1]=__builtin_amdgcn_mfma_f32_32x32x16_bf16(PAF(2),VFR(6),o[1],0,0,0), C1,4); \
    GAPB(o[0]=__builtin_amdgcn_mfma_f32_32x32x16_bf16(PAF(3),VFR(3),o[0],0,0,0), C1,8); \
    GAPB(o[1]=__builtin_amdgcn_mfma_f32_32x32x16_bf16(PAF(3),VFR(7),o[1],0,0,0), C1,12); \
    }while(0)
  int t=1;
  #undef CMASK
  #define CMASK(P0,P1,t) do{}while(0)
  for(;t+5<NT;t+=2){
    STEP(pB0,pB1,pA0,pA1,t,true,true,true,true);     WAIT_BAR(3); RESC(); NEXTL(t+1); ROT();
    STEP(pA0,pA1,pB0,pB1,t+1,true,true,true,true);   WAIT_BAR(3); RESC(); NEXTL(t+2); ROT();
  }
  #undef CMASK
  #define CMASK(P0,P1,t) do{int jb_=(t)-(NT-4); if(jb_>=0)cmask(P0,P1,jb_,qrel,hi);}while(0)
  #define ENDW(tt) do{ if((tt)+3<NT){WAIT_BAR(3);} else if((tt)+2<NT){WAIT_BAR(2);} else {WAIT_BAR(0);} }while(0)
  for(;t+1<NT;t+=2){
    STEP(pB0,pB1,pA0,pA1,t,(t+3<NT),(t+1<NT),(t+1<NT),(t+2<NT));       ENDW(t);   RESC(); NEXTL(t+1); ROT();
    STEP(pA0,pA1,pB0,pB1,t+1,(t+4<NT),(t+2<NT),(t+2<NT),(t+3<NT));     ENDW(t+1); RESC(); NEXTL(t+2); ROT();
  }
  STEP(pB0,pB1,pA0,pA1,NT-1,false,false,false,false); RESC();
  { float sacc=pB0[0]+pB0[1]; _Pragma("unroll") for(int r=2;r<16;++r)sacc+=pB0[r]; _Pragma("unroll") for(int r=0;r<16;++r)sacc+=pB1[r]; l_reg+=sacc;
    pw0=(u32x4){PKW(pB0,0),PKW(pB0,2),PKW(pB0,4),PKW(pB0,6)};pw1=(u32x4){PKW(pB0,8),PKW(pB0,10),PKW(pB0,12),PKW(pB0,14)};pw2=(u32x4){PKW(pB1,0),PKW(pB1,2),PKW(pB1,4),PKW(pB1,6)};pw3=(u32x4){PKW(pB1,8),PKW(pB1,10),PKW(pB1,12),PKW(pB1,14)};
    SBAR(); pv(o,vb0+sl_cur,PAF(0),PAF(1),PAF(2),PAF(3)); }
  #undef PKW
  #undef PAF
  #undef VFR
  #undef PIN
  #undef MX3
  #undef GAPA
  #undef GAPB
  #undef EX
  #undef VRD
  #undef KRD
  #undef STEP
  #undef ENDW
  #undef NEXTB
  #undef NEXTL
  #undef FLOAD
  {auto rr=__builtin_amdgcn_permlane32_swap(__float_as_uint(l_reg),__float_as_uint(l_reg),false,false);l_reg=__uint_as_float(rr[0])+__uint_as_float(rr[1]);}
  if(hi==0)wsf[32+r32]=l_reg;asm volatile("s_waitcnt lgkmcnt(0)":::"memory");
  float rli[16];
  #pragma unroll
  for(int r=0;r<16;++r)rli[r]=__builtin_amdgcn_rcpf(wsf[32+crow(r,hi)]);
  bf16*Ow=O+(rowbase+q0+wid*QBLK)*OP+h*D;
  { bf16*stg=(bf16*)(shm+LDS_OST)+wid*2048;
    #pragma unroll
    for(int r=0;r<16;++r){const int orow=crow(r,hi);
      #pragma unroll
      for(int d0=0;d0<2;++d0)stg[orow*64+d0*32+r32]=__float2bfloat16(o[d0][r]*rli[r]);}
    asm volatile("s_waitcnt lgkmcnt(0)":::"memory");
    #pragma unroll
    for(int i=0;i<4;++i){const int row=i*8+(lane>>3),ch=lane&7; const u32x4 v=*(const u32x4*)(stg+row*64+ch*8); *(u32x4*)(Ow+(long)row*OP+ch*8)=v;} }
  asm volatile("s_waitcnt lgkmcnt(0)\n\ts_barrier":::"memory");
  #undef DMA_K
  #undef DMA_V
  #undef CMASK
  #undef START
  #undef RESC
  #undef ROT
}
constexpr int ATTN_LDS_BYTES=LDS_BYTES;
#undef SBAR
#undef WAIT_BAR
#undef AUGM
}

constexpr int NWAVES = 8;
constexpr int BATCH = 2, SEQ = 8192, T = BATCH * SEQ, D = 1024, DEPTH = 4;
constexpr int NZ = 2560, NINP = 2816;
constexpr int NE = 32, TOPK = 4, MROWS = 73728;
constexpr float LN_EPS = 1e-5f, RMS_EPS = 1e-6f, DN_ALPHA = 1.6817928305074290f;
constexpr int FOXH = 6, GLAH = 4, GDK = 48, GDV = 96, GCH = 64, NCHUNK = SEQ / GCH;

constexpr size_t MiB = 1u << 20;
constexpr size_t WS_CTL = 0, CTL_ZERO_BYTES = 1 * MiB;
constexpr size_t WS_MODP = 1 * MiB;
constexpr size_t WS_MOD = 3 * MiB;
constexpr size_t WS_BINP = 3 * MiB + 512 * 1024;
constexpr size_t WS_WRT = 4 * MiB;
constexpr size_t WS_FCUM = 5 * MiB;
constexpr size_t WS_LF = 5 * MiB + 512 * 1024;
constexpr size_t WS_TOKE = 6 * MiB;
constexpr size_t WS_TOKS = 6 * MiB + 512 * 1024;
constexpr size_t WS_TOKG = 7 * MiB;
constexpr size_t WS_LIST = 12 * MiB;
constexpr size_t WS_DEC = 8 * MiB;
constexpr size_t WS_ZF = 10 * MiB;
constexpr size_t WS_WIN = 16 * MiB;
constexpr size_t WS_WOUT = 40 * MiB;
constexpr size_t WS_WGU = 64 * MiB;
constexpr size_t WS_WDN = 576 * MiB;
constexpr size_t WS_X0 = 832 * MiB, WS_X1 = 896 * MiB, WS_Y = 960 * MiB;
constexpr size_t WS_H = 1024 * MiB, WS_H2 = 1056 * MiB, WS_MIX = 1088 * MiB;
constexpr size_t WS_Z = 1120 * MiB;
constexpr size_t WS_KV = 1200 * MiB, WS_ST = 1220 * MiB;
constexpr size_t WS_QIN = 1232 * MiB, WS_KIN = 1240 * MiB;
constexpr size_t WS_WPT = 1248 * MiB;
constexpr size_t WS_XROWS = 1280 * MiB, WS_ACT = 1424 * MiB, WS_YROWS = 1568 * MiB;
constexpr size_t WS_END = 1712 * MiB;
constexpr int CW_BAR = 4096;
constexpr int CW_CNT = 16384;
constexpr int CW_RDY = 65536;
constexpr int CW_CONVQ = 44032;
constexpr int CW_NRM = 43008;
constexpr int CW_TAILQ = 40960, CW_SCAN = 41984;

constexpr int RING_OFF = 0, RING_BYTES = 131072;
constexpr int LDSCTL_OFF = RING_BYTES, MISC_OFF = LDSCTL_OFF + 320;
constexpr int LX_TAB = MISC_OFF + 128;
constexpr int LX_PST = LX_TAB + 320 * 4;
constexpr int LX_CNT = LX_PST + 64 * 4;
constexpr int LX_HIST = LX_CNT + 64 * 4;
constexpr int LX_SCR = LX_HIST + 64 * 4;
constexpr int LDS_BYTES = 147456;
static_assert(LX_SCR + 2048 + 64 + 64 <= RING_OFF + pg8::TOKL_OFF && RING_OFF + pg8::TOKL_OFF + 8192 <= LDS_BYTES, "LDS map");

#define GAS __attribute__((address_space(1)))
#define LAS __attribute__((address_space(3)))
typedef unsigned short bf16;
typedef unsigned v4u __attribute__((ext_vector_type(4)));
typedef float f32x4 __attribute__((ext_vector_type(4)));
typedef short bf16x8 __attribute__((ext_vector_type(8)));
typedef GAS unsigned gu32;
typedef GAS unsigned long long gu64;
#define RLX_AGENT __ATOMIC_RELAXED, __HIP_MEMORY_SCOPE_AGENT
#define LDS_WAIT() asm volatile("s_waitcnt lgkmcnt(0)" ::: "memory")
#define VM_WAIT() asm volatile("s_waitcnt vmcnt(0)" ::: "memory")
__device__ __forceinline__ unsigned long long rt() { return __builtin_amdgcn_s_memrealtime(); }
__device__ __forceinline__ unsigned pk2(float lo, float hi) { return pg8::cvt_pk_bf16(lo, hi); }
__device__ __forceinline__ unsigned f2bf(float f) { return pg8::cvt_pk_bf16(f, 0.f) & 0xffffu; }

#define XB_TMO      128
#define XB_XCNT(j)  (256  + 64 * (j))
#define XB_XSUB(j)  (1280 + 64 * (j))
#define XB_XGEN(j)  (2304 + 64 * (j))
#define XB_TOP      3328
#define XB_TOPGEN   3392
#define XCD_BAR_WORDS 3456
#define XB_SPIN_CAP (1u << 18)

__device__ __forceinline__ unsigned xb_ld(unsigned* p)              { return __hip_atomic_load(p, __ATOMIC_RELAXED, __HIP_MEMORY_SCOPE_AGENT); }
__device__ __forceinline__ unsigned xb_add(unsigned* p, unsigned v) { return __hip_atomic_fetch_add(p, v, __ATOMIC_RELAXED, __HIP_MEMORY_SCOPE_AGENT); }
__device__ __forceinline__ unsigned xb_xcc_id() { return (unsigned)__builtin_amdgcn_s_getreg((3 << 11) | 20) & 0xFu; }
#define XB_SPIN(cond, bar) do { unsigned _sp = 0; while (cond) { __builtin_amdgcn_s_sleep(1); \
    if ((++_sp & 255u) == 0u) { if (xb_ld(&(bar)[XB_TMO])) break; if (_sp > XB_SPIN_CAP) { atomicAdd(&(bar)[XB_TMO], 1u); break; } } } } while (0)

struct XcdBarrier {
    unsigned* bar; unsigned x;
    volatile LAS unsigned* st;
};

__device__ __forceinline__ XcdBarrier xcd_barrier_post(unsigned* bar, volatile LAS unsigned* st) {
    XcdBarrier b; b.bar = bar; b.x = xb_xcc_id(); b.st = st;
    if (threadIdx.x == 0) (void)xb_add(&bar[XB_XCNT(b.x)], 1u);
    return b;
}
__device__ __forceinline__ void xcd_barrier_complete(unsigned* bar, unsigned x, unsigned& nloc, unsigned& nx) {
    const unsigned G = gridDim.x * gridDim.y * gridDim.z;
    unsigned sum, cnt, mine, sp = 0u;
    for (;;) {
        sum = 0u; cnt = 0u; mine = 0u;
#pragma unroll
        for (unsigned j = 0; j < 16; ++j) { const unsigned c = xb_ld(&bar[XB_XCNT(j)]); sum += c; cnt += (c > 0u) ? 1u : 0u; mine = (j == x) ? c : mine; }
        if (sum == G) break;
        __builtin_amdgcn_s_sleep(1);
        if ((++sp & 255u) == 0u) { if (xb_ld(&bar[XB_TMO])) break; if (sp > XB_SPIN_CAP) { atomicAdd(&bar[XB_TMO], 1u); break; } }
    }
    nloc = mine > 0u ? mine : 1u; nx = cnt > 0u ? cnt : 1u;
}

__device__ __forceinline__ void xcd_barrier(const XcdBarrier& b) {
    asm volatile("s_waitcnt vmcnt(0)" ::: "memory");
    __syncthreads();
    if (threadIdx.x == 0) {
        unsigned* bar = b.bar;
        __builtin_amdgcn_s_waitcnt(0);
        unsigned nloc = b.st[0], nx = b.st[1];
        if (nloc == 0u) { xcd_barrier_complete(bar, b.x, nloc, nx); b.st[0] = nloc; b.st[1] = nx; }
        const unsigned old = xb_add(&bar[XB_XSUB(b.x)], 1u);
        const unsigned gen = old / nloc;
        if (old + 1u == (gen + 1u) * nloc) {
            __builtin_amdgcn_fence(__ATOMIC_RELEASE, "agent");
            asm volatile("s_waitcnt vmcnt(0)" ::: "memory");
            const unsigned og = xb_add(&bar[XB_TOP], 1u);
            const unsigned tg = og / nx;
            if (og + 1u == (tg + 1u) * nx) xb_add(&bar[XB_TOPGEN], 1u);
            else XB_SPIN(xb_ld(&bar[XB_TOPGEN]) == tg, bar);
            __builtin_amdgcn_fence(__ATOMIC_ACQUIRE, "agent");
            xb_add(&bar[XB_XGEN(b.x)], 1u);
            asm volatile("s_waitcnt vmcnt(0)" ::: "memory");
        } else {
            XB_SPIN(xb_ld(&bar[XB_XGEN(b.x)]) == gen, bar);
            __builtin_amdgcn_fence(__ATOMIC_ACQUIRE, "agent");
            asm volatile("s_waitcnt vmcnt(0)" ::: "memory");
        }
    }
    __syncthreads();
}

struct Frame {
    LAS unsigned char* lds;
    volatile LAS unsigned* MISC;
    gu32* ctl;
    unsigned char* ws;
    int tid, lane, wave;
    int vcu, G;
};
__device__ __forceinline__ float wave_sum(float v) {
#define WS_DPP(x, ctrl) __builtin_bit_cast(float, __builtin_amdgcn_update_dpp(0, __builtin_bit_cast(int, (x)), (ctrl), 0xf, 0xf, false))
    v += WS_DPP(v, 0xB1); v += WS_DPP(v, 0x4E); v += WS_DPP(v, 0x141); v += WS_DPP(v, 0x140);
#undef WS_DPP
    const int iv = __builtin_bit_cast(int, v);
    return (__builtin_bit_cast(float, __builtin_amdgcn_readlane(iv, 0)) + __builtin_bit_cast(float, __builtin_amdgcn_readlane(iv, 16))) + (__builtin_bit_cast(float, __builtin_amdgcn_readlane(iv, 32)) + __builtin_bit_cast(float, __builtin_amdgcn_readlane(iv, 48)));
}
__device__ __forceinline__ float bf2f(unsigned v) { return __builtin_bit_cast(float, v << 16); }
__device__ __forceinline__ float log_sigmoidf(float x) { return fminf(x, 0.f) - __logf(1.0f + __expf(-fabsf(x))); }
__device__ __forceinline__ float siluf(float x) { return x * __builtin_amdgcn_rcpf(1.f + __expf(-x)); }
__device__ __forceinline__ f32x4 bf4_to_f32(unsigned long long w) { const unsigned lo = (unsigned)w, hi = (unsigned)(w >> 32); return (f32x4){bf2f(lo & 0xffffu), bf2f(lo >> 16), bf2f(hi & 0xffffu), bf2f(hi >> 16)}; }
__device__ __forceinline__ unsigned long long f32_to_bf4(f32x4 v) { return (unsigned long long)pk2(v.x, v.y) | ((unsigned long long)pk2(v.z, v.w) << 32); }
#define REFRESH_F() do { F.tid = opaque_tid(); F.lane = F.tid & 63; F.wave = __builtin_amdgcn_readfirstlane(F.tid >> 6); } while (0)
#define WG_SYNC() do { asm volatile("s_waitcnt vmcnt(0) lgkmcnt(0)" ::: "memory"); __syncthreads(); } while (0)

__device__ __forceinline__ void p0_tr_item(const float* W, int Nsrc, bf16* WT, int K, int n0, int k0, int kind, LAS float* scr, int lane) {
    const int n = n0 + (lane & 31);
    int col; float sc = 1.f;
    if (kind == 0) col = n;
    else if (kind == 1) { if (n < 1152) { col = n; if (n < 384) sc = attn_body::C2; } else if (n < 2304) col = n + 6; else if (n < 2560) col = n + 22; else if (n < 2566) col = n - 2560 + 1152; else if (n < 2582) col = n - 2566 + 2310; else col = -1; }
    else { const int pn = n >> 8, rr = n & 255; col = rr < 128 ? 128 * pn + rr : 1024 + 128 * pn + rr - 128; }
    float tv[32];
#pragma unroll
    for (int i = 0; i < 32; ++i) { const int kk = 2 * i + (lane >> 5); tv[i] = col >= 0 ? W[(size_t)(k0 + kk) * Nsrc + col] : 0.f; }
#pragma unroll
    for (int i = 0; i < 32; ++i) { const int kk = 2 * i + (lane >> 5); scr[kk * 33 + (lane & 31)] = tv[i] * sc; }
    LDS_WAIT(); asm volatile("" ::: "memory");
    const int c = lane & 7;
#pragma unroll
    for (int j = 0; j < 4; ++j) { const int nn = (lane >> 3) + 8 * j; const LAS float* s = scr + (8 * c) * 33 + nn;
        v4u o; o.x = pk2(s[0 * 33], s[1 * 33]); o.y = pk2(s[2 * 33], s[3 * 33]); o.z = pk2(s[4 * 33], s[5 * 33]); o.w = pk2(s[6 * 33], s[7 * 33]);
        *(GAS v4u*)(WT + (size_t)(n0 + nn) * K + k0 + 8 * c) = o; }
    LDS_WAIT(); asm volatile("" ::: "memory");
}
__device__ __forceinline__ void p0_tr_item_fp8(const float* W, int Nsrc, unsigned char* WT, int K, int n0, int k0, int kind, float scale, LAS float* scr, int lane) {
    const int n = n0 + (lane & 31);
    int col;
    if (kind == 0) col = n; else { const int pn = n >> 8, rr = n & 255; col = rr < 128 ? 128 * pn + rr : 1024 + 128 * pn + rr - 128; }
    float tv[32];
#pragma unroll
    for (int i = 0; i < 32; ++i) { const int kk = 2 * i + (lane >> 5); tv[i] = W[(size_t)(k0 + kk) * Nsrc + col]; }
#pragma unroll
    for (int i = 0; i < 32; ++i) { const int kk = 2 * i + (lane >> 5); scr[kk * 33 + (lane & 31)] = tv[i] * scale; }
    LDS_WAIT(); asm volatile("" ::: "memory");
    const int c = lane & 3;
#pragma unroll
    for (int j = 0; j < 2; ++j) { const int nn = (lane >> 2) + 16 * j; const LAS float* s = scr + (16 * c) * 33 + nn;
        v4u o; o.x = pg8::pk4_fp8(s[0 * 33], s[1 * 33], s[2 * 33], s[3 * 33]); o.y = pg8::pk4_fp8(s[4 * 33], s[5 * 33], s[6 * 33], s[7 * 33]);
        o.z = pg8::pk4_fp8(s[8 * 33], s[9 * 33], s[10 * 33], s[11 * 33]); o.w = pg8::pk4_fp8(s[12 * 33], s[13 * 33], s[14 * 33], s[15 * 33]);
        *(GAS v4u*)(WT + (size_t)(n0 + nn) * K + k0 + 16 * c) = o; }
    LDS_WAIT(); asm volatile("" ::: "memory");
}
struct P0It { const float* src; int stride; float sc; unsigned char* dst; int n0, k0, fp8; };
__device__ __forceinline__ P0It p0_decode(Frame& F, const float* const* in, int r, int lane) {
    constexpr int I_IN = DEPTH * 88 * 16, I_OUT = DEPTH * 32 * 16, I_GU = DEPTH * NE * 64 * 16;
    P0It t; int kind, nb, Nsrc; const float* W;
    if (r < I_IN) { const int l = r / (88 * 16), q = r % (88 * 16); nb = 88; kind = 1; Nsrc = 2582; W = in[4] + (size_t)l * D * 2582; t.dst = F.ws + WS_WIN + (size_t)l * NINP * D * 2; t.fp8 = 0; t.sc = 1.f; t.n0 = ((q >> 1) % nb) * 32; t.k0 = (((q >> 1) / nb) * 2 + (q & 1)) * 64; }
    else if ((r -= I_IN) < I_OUT) { const int l = r / (32 * 16), q = r % (32 * 16); nb = 32; kind = 0; Nsrc = D; W = in[11] + (size_t)l * D * D; t.dst = F.ws + WS_WOUT + (size_t)l * D * D * 2; t.fp8 = 0; t.sc = 1.f; t.n0 = ((q >> 1) % nb) * 32; t.k0 = (((q >> 1) / nb) * 2 + (q & 1)) * 64; }
    else if ((r -= I_OUT) < I_GU) { const int le = r / (64 * 16), q = r % (64 * 16); nb = 64; kind = 2; Nsrc = 2048; W = in[16] + (size_t)le * D * 2048; t.dst = F.ws + WS_WGU + (size_t)le * 2048 * D; t.fp8 = 1; t.sc = 32.f; t.n0 = ((q >> 1) % nb) * 32; t.k0 = (((q >> 1) / nb) * 2 + (q & 1)) * 64; }
    else { r -= I_GU; const int le = r / (32 * 16), q = r % (32 * 16); nb = 32; kind = 0; Nsrc = D; W = in[18] + (size_t)le * D * D; t.dst = F.ws + WS_WDN + (size_t)le * D * D; t.fp8 = 1; t.sc = 64.f; t.n0 = ((q >> 1) % nb) * 32; t.k0 = (((q >> 1) / nb) * 2 + (q & 1)) * 64; }
    const int n = t.n0 + (lane & 31); int col;
    if (kind == 0) col = n;
    else if (kind == 1) { if (n < 1152) { col = n; if (n < 384) t.sc = attn_body::C2; } else if (n < 2304) col = n + 6; else if (n < 2560) col = n + 22; else if (n < 2566) col = n - 2560 + 1152; else if (n < 2582) col = n - 2566 + 2310; else col = -1; }
    else { const int pn = n >> 8, rr = n & 255; col = rr < 128 ? 128 * pn + rr : 1024 + 128 * pn + rr - 128; }
    t.stride = Nsrc; t.src = col >= 0 ? W + (size_t)(t.k0 + (lane >> 5)) * Nsrc + col : nullptr;
    return t;
}
#define P0_ISSUE(T, TV) do { _Pragma("unroll") for (int i = 0; i < 32; ++i) TV[i] = (T).src ? __builtin_nontemporal_load((T).src + (size_t)(2 * i) * (T).stride) : 0.f; } while (0)
__device__ __forceinline__ void p0_finish(const P0It& t, const float (&tv)[32], LAS float* scr, int lane) {
#pragma unroll
    for (int i = 0; i < 32; ++i) { const int kk = 2 * i + (lane >> 5); scr[kk * 33 + (lane & 31)] = tv[i] * t.sc; }
    LDS_WAIT(); asm volatile("" ::: "memory");
    if (t.fp8) { const int c = lane & 3;
#pragma unroll
        for (int j = 0; j < 2; ++j) { const int nn = (lane >> 2) + 16 * j; const LAS float* s = scr + (16 * c) * 33 + nn;
            v4u o; o.x = pg8::pk4_fp8(s[0 * 33], s[1 * 33], s[2 * 33], s[3 * 33]); o.y = pg8::pk4_fp8(s[4 * 33], s[5 * 33], s[6 * 33], s[7 * 33]);
            o.z = pg8::pk4_fp8(s[8 * 33], s[9 * 33], s[10 * 33], s[11 * 33]); o.w = pg8::pk4_fp8(s[12 * 33], s[13 * 33], s[14 * 33], s[15 * 33]);
            *(GAS v4u*)(t.dst + (size_t)(t.n0 + nn) * D + t.k0 + 16 * c) = o; } }
    else { const int c = lane & 7;
#pragma unroll
        for (int j = 0; j < 4; ++j) { const int nn = (lane >> 3) + 8 * j; const LAS float* s = scr + (8 * c) * 33 + nn;
            v4u o; o.x = pk2(s[0 * 33], s[1 * 33]); o.y = pk2(s[2 * 33], s[3 * 33]); o.z = pk2(s[4 * 33], s[5 * 33]); o.w = pk2(s[6 * 33], s[7 * 33]);
            *(GAS v4u*)((bf16*)t.dst + (size_t)(t.n0 + nn) * D + t.k0 + 8 * c) = o; } }
    LDS_WAIT(); asm volatile("" ::: "memory");
}
constexpr int CONV_ITEMS_PER_LAYER = NE * 64 * 16 + NE * 32 * 16, CONV_GRANULES = CONV_ITEMS_PER_LAYER / 32;
struct P0It4 { const float* src; int stride; float sc; unsigned char* dst; int n0, k0; };
__device__ __forceinline__ P0It4 p0_decode4(Frame& F, const float* const* in, int L, int li, int lane) {
    constexpr int GU_L = NE * 64 * 16;
    P0It4 t; int col, Nsrc; const float* W; const int n4 = 4 * (lane & 7);
    if (li < GU_L) { const int e = li / (64 * 16), q = li % (64 * 16), le = L * NE + e; Nsrc = 2048; W = in[16] + (size_t)le * D * 2048; t.dst = F.ws + WS_WGU + (size_t)le * 2048 * D; t.sc = 32.f;
        t.n0 = ((q >> 1) % 64) * 32; t.k0 = (((q >> 1) / 64) * 2 + (q & 1)) * 64; const int n = t.n0 + n4, pn = n >> 8, rr = n & 255; col = rr < 128 ? 128 * pn + rr : 1024 + 128 * pn + rr - 128; }
    else { li -= GU_L; const int e = li / (32 * 16), q = li % (32 * 16), le = L * NE + e; Nsrc = D; W = in[18] + (size_t)le * D * D; t.dst = F.ws + WS_WDN + (size_t)le * D * D; t.sc = 64.f;
        t.n0 = ((q >> 1) % 32) * 32; t.k0 = (((q >> 1) / 32) * 2 + (q & 1)) * 64; col = t.n0 + n4; }
    t.stride = Nsrc; t.src = W + (size_t)(t.k0 + (lane >> 3)) * Nsrc + col;
    return t;
}
#define P0_ISSUE4(T, TQ) do { _Pragma("unroll") for (int i = 0; i < 8; ++i) TQ[i] = __builtin_nontemporal_load((const f32x4*)((T).src + (size_t)(8 * i) * (T).stride)); } while (0)
__device__ __forceinline__ void p0_finish4x2(const P0It4& tA, const f32x4 (&qA)[8], const P0It4& tB, const f32x4 (&qB)[8], LAS float* scrf, int lane) {
    LAS unsigned* scr = (LAS unsigned*)scrf;
#pragma unroll
    for (int i = 0; i < 8; ++i) { const int off = (lane & 7) * 68 + 8 * i + (lane >> 3);
        scr[off] = pg8::pk4_fp8(qA[i].x * tA.sc, qA[i].y * tA.sc, qA[i].z * tA.sc, qA[i].w * tA.sc);
        scr[576 + off] = pg8::pk4_fp8(qB[i].x * tB.sc, qB[i].y * tB.sc, qB[i].z * tB.sc, qB[i].w * tB.sc); }
    LDS_WAIT(); asm volatile("" ::: "memory");
    { const int l32 = lane & 31, kq = l32 & 3, g = l32 >> 2; const bool isB = lane >= 32;
      const LAS unsigned* src = scr + (isB ? 576 : 0) + g * 68 + 16 * kq;
      unsigned o[4][4];
#pragma unroll
      for (int blk = 0; blk < 4; ++blk) { const v4u r4 = *(const LAS v4u*)(src + 4 * blk);
          const unsigned t0 = __builtin_amdgcn_perm(r4.y, r4.x, 0x05010400u), t1 = __builtin_amdgcn_perm(r4.y, r4.x, 0x07030602u), t2 = __builtin_amdgcn_perm(r4.w, r4.z, 0x05010400u), t3 = __builtin_amdgcn_perm(r4.w, r4.z, 0x07030602u);
          o[0][blk] = __builtin_amdgcn_perm(t2, t0, 0x05040100u); o[1][blk] = __builtin_amdgcn_perm(t2, t0, 0x07060302u); o[2][blk] = __builtin_amdgcn_perm(t3, t1, 0x05040100u); o[3][blk] = __builtin_amdgcn_perm(t3, t1, 0x07060302u); }
      unsigned char* dst = isB ? tB.dst : tA.dst; const int n0 = isB ? tB.n0 : tA.n0, k0 = isB ? tB.k0 : tA.k0;
#pragma unroll
      for (int j = 0; j < 4; ++j) { v4u w; w.x = o[j][0]; w.y = o[j][1]; w.z = o[j][2]; w.w = o[j][3]; __builtin_nontemporal_store(w, (v4u*)(dst + (size_t)(n0 + 4 * g + j) * D + k0 + 16 * kq)); } }
    LDS_WAIT(); asm volatile("" ::: "memory");
}
__device__ __forceinline__ void conv_run(Frame& F, const float* const* in, int L, gu32* qv, LAS int* slot) {
    LAS float* scr = (LAS float*)(F.lds + RING_OFF + F.wave * 16384); const int lane = F.lane;
    unsigned nreq = 0u;
    if (F.tid == 0) { *slot = (int)__hip_atomic_fetch_add(qv, 1u, RLX_AGENT); nreq = __hip_atomic_fetch_add(qv, 1u, RLX_AGENT); }
    WG_SYNC();
    int gi = __builtin_amdgcn_readfirstlane(*slot);
    WG_SYNC();
    if (gi >= CONV_GRANULES) return;
    f32x4 tqA[8], tqB[8], tqC[8], tqD[8]; P0It4 tA, tB, tC, tD;
    { const int li0 = 32 * gi + 4 * F.wave;
      tA = p0_decode4(F, in, L, li0, lane); tB = p0_decode4(F, in, L, li0 + 1, lane); tC = p0_decode4(F, in, L, li0 + 2, lane); tD = p0_decode4(F, in, L, li0 + 3, lane);
      P0_ISSUE4(tA, tqA); P0_ISSUE4(tB, tqB); P0_ISSUE4(tC, tqC); P0_ISSUE4(tD, tqD); }
    for (;;) {
        if (F.tid == 0) *slot = (int)nreq;
        WG_SYNC();
        const int gn = __builtin_amdgcn_readfirstlane(*slot); const bool more = gn < CONV_GRANULES;
        if (F.tid == 0 && more) nreq = __hip_atomic_fetch_add(qv, 1u, RLX_AGENT);
        const int ln0 = 32 * gn + 4 * F.wave;
        const P0It4 uA = tA, uB = tB;
        p0_finish4x2(uA, tqA, uB, tqB, scr, lane);
        if (more) { tA = p0_decode4(F, in, L, ln0, lane); tB = p0_decode4(F, in, L, ln0 + 1, lane); P0_ISSUE4(tA, tqA); P0_ISSUE4(tB, tqB); }
        const P0It4 uC = tC, uD = tD;
        p0_finish4x2(uC, tqC, uD, tqD, scr, lane);
        if (more) { tC = p0_decode4(F, in, L, ln0 + 2, lane); tD = p0_decode4(F, in, L, ln0 + 3, lane); P0_ISSUE4(tC, tqC); P0_ISSUE4(tD, tqD); }
        WG_SYNC();
        if (!more) break;
    }
}
__device__ __forceinline__ void ph_convert(Frame& F, const float* const* in) {
    LAS float* scr = (LAS float*)(F.lds + RING_OFF + F.wave * 16384);
    const int gw = F.vcu * NWAVES + F.wave, NGW = F.G * NWAVES, lane = F.lane;
    constexpr int I_IN = DEPTH * 88 * 16, I_OUT = DEPTH * 32 * 16, I_GU = DEPTH * NE * 64 * 16, I_DN = DEPTH * NE * 32 * 16, I_MOD = DEPTH * 8 * 96, I_WR = DEPTH * 16;
    for (int r = gw; r < I_MOD + I_WR; r += NGW) {
        if (r < I_MOD) {
            const int l = r / 768, q = r % 768, kp = q / 96, j = (q % 96) * 64 + lane;
            const float* c = in[1]; const float* wa = in[2] + ((size_t)l * D + kp * 128) * 6144 + j;
            float a0 = 0.f, a1 = 0.f;
#pragma unroll 16
            for (int k = 0; k < 128; ++k) { const float w = wa[(size_t)k * 6144]; a0 += siluf(c[kp * 128 + k]) * w; a1 += siluf(c[D + kp * 128 + k]) * w; }
            float* mp = (float*)(F.ws + WS_MODP) + ((size_t)(l * 8 + kp) * 2) * 6144 + j; mp[0] = a0; mp[6144] = a1; }
        else { const int rw = r - I_MOD;
            const int l = rw / 16, k0 = (rw % 16) * 64; const float* wr = in[14] + (size_t)l * D * NE; float* wt = (float*)(F.ws + WS_WRT) + (size_t)l * NE * D;
            for (int i = 0; i < 32; ++i) { const int idx = i * 64 + lane, kk = idx >> 5, e = idx & 31; scr[e * 65 + kk] = wr[(size_t)(k0 + kk) * NE + e]; }
            LDS_WAIT(); asm volatile("" ::: "memory");
            for (int e = 0; e < 32; ++e) wt[(size_t)e * D + k0 + lane] = scr[e * 65 + lane];
            LDS_WAIT(); asm volatile("" ::: "memory"); }
    }
    { constexpr int NIT = I_IN + I_OUT;
      (void)I_DN; (void)I_GU;
#define P0R(i) ((i) < I_IN + I_OUT + I_GU / DEPTH ? (i) : (i) + (I_GU - I_GU / DEPTH))
      float tvA[32], tvB[32]; P0It tA, tB; int it = 2 * gw;
      if (it < NIT) { tA = p0_decode(F, in, P0R(it), lane); P0_ISSUE(tA, tvA); }
      for (; it < NIT; it += 2 * NGW) {
          tB = p0_decode(F, in, P0R(it + 1), lane); P0_ISSUE(tB, tvB);
          p0_finish(tA, tvA, scr, lane);
          if (it + 2 * NGW < NIT) { tA = p0_decode(F, in, P0R(it + 2 * NGW), lane); P0_ISSUE(tA, tvA); }
          p0_finish(tB, tvB, scr, lane); }
#undef P0R
    }
    for (int i = (F.vcu * NWAVES + F.wave) * 64 + lane; i < DEPTH * 4 * 64 * 64; i += NGW * 64) { const int lg = i >> 12, d = (i >> 6) & 63, c = i & 63; ((bf16*)(F.ws + WS_WPT))[i] = (bf16)f2bf(in[9][(size_t)(lg * 64 + c) * 64 + d]); }
    for (int i = (F.vcu * NWAVES + F.wave) * 64 + lane; i < DEPTH * NINP; i += NGW * 64) {
        const int l = i / NINP, n = i % NINP; int col; float sc = 1.f;
        if (n < 1152) { col = n; if (n < 384) sc = attn_body::C2; } else if (n < 2304) col = n + 6; else if (n < 2560) col = n + 22; else if (n < 2566) col = n - 2560 + 1152; else if (n < 2582) col = n - 2566 + 2310; else col = -1;
        ((float*)(F.ws + WS_BINP))[i] = col >= 0 ? in[5][(size_t)l * 2582 + col] * sc : 0.f;
    }
}
__device__ __forceinline__ void ph_modfin(Frame& F, const float* const* in) {
    const float* mp = (const float*)(F.ws + WS_MODP); float* mod = (float*)(F.ws + WS_MOD);
    for (int i = F.vcu * 512 + F.tid; i < DEPTH * 2 * 6144; i += F.G * 512) {
        const int l = i / 12288, q = i % 12288, b = q / 6144, j = q % 6144;
        float s = in[3][(size_t)l * 6144 + j];
#pragma unroll
        for (int p = 0; p < 8; ++p) s += mp[((size_t)(l * 8 + p) * 2 + b) * 6144 + j];
        mod[i] = s;
    }
}
__device__ __forceinline__ void ph_mod0(Frame& F, const float* x) {
    const int gw = F.vcu * NWAVES + F.wave, NGW = F.G * NWAVES, lane = F.lane;
    const float* mod = (const float*)(F.ws + WS_MOD); bf16* H = (bf16*)(F.ws + WS_H);
    for (int m = gw; m < T; m += NGW) {
        const int b = m >> 13; const float* mb = mod + (size_t)b * 6144;
        const GAS f32x4* xr = (const GAS f32x4*)(x + (size_t)m * D) + lane;
        GAS unsigned long long* o8 = (GAS unsigned long long*)(H + (size_t)m * D) + lane;
        GAS unsigned long long* x8 = (GAS unsigned long long*)((bf16*)(F.ws + WS_X0) + (size_t)m * D) + lane;
#pragma unroll
        for (int j = 0; j < 4; ++j) { const f32x4 v = xr[64 * j]; const int c0 = 256 * j + 4 * lane;
            const f32x4 sh = *(const f32x4*)(mb + c0), sc = *(const f32x4*)(mb + 1024 + c0);
            const f32x4 h = v * (sc + 1.0f) + sh;
            x8[64 * j] = f32_to_bf4(v);
            o8[64 * j] = (unsigned long long)pk2(h.x, h.y) | ((unsigned long long)pk2(h.z, h.w) << 32); }
    }
}

typedef float f32x16 __attribute__((ext_vector_type(16)));
typedef unsigned short u16x4 __attribute__((ext_vector_type(4)));
__device__ __forceinline__ f32x16 mfma32(bf16x8 a, bf16x8 b, f32x16 c) { return __builtin_amdgcn_mfma_f32_32x32x16_bf16(a, b, c, 0, 0, 0); }
__device__ __forceinline__ int crow(int r, int hi) { return (r & 3) + 8 * (r >> 2) + 4 * hi; }
__device__ __forceinline__ void ph_fcum(Frame& F) {
    const float* LFp = (const float*)(F.ws + WS_LF); float* FC = (float*)(F.ws + WS_FCUM);
    LAS float* wtot = (LAS float*)(F.lds + LX_SCR);
    for (int u = blockIdx.x; u < BATCH * FOXH; u += F.G) {
        const int b = u / FOXH, h = u % FOXH, t0 = F.tid * 16;
        float v[16]; float run = 0.f;
#pragma unroll
        for (int k4 = 0; k4 < 4; ++k4) { const f32x4 q = *(const f32x4*)(LFp + (size_t)u * SEQ + t0 + 4 * k4);
#pragma unroll
            for (int j = 0; j < 4; ++j) { run += q[j]; v[4 * k4 + j] = run; } }
        float inc = run;
#pragma unroll
        for (int off = 1; off < 64; off <<= 1) { const float y = __shfl_up(inc, off); if (F.lane >= off) inc += y; }
        if (F.lane == 63) wtot[F.wave] = inc;
        WG_SYNC();
        float base = 0.f;
        for (int w = 0; w < F.wave; ++w) base += wtot[w];
        const float excl = base + inc - run;
#pragma unroll
        for (int k = 0; k < 16; ++k) FC[(size_t)u * SEQ + t0 + k] = excl + v[k];
        WG_SYNC();
    }
}
__device__ __forceinline__ void ph_qknorm(Frame& F, gu32* nrm) {
    const bf16* Z = (const bf16*)(F.ws + WS_Z); const int lane = F.lane;
    LAS float* red = (LAS float*)(F.lds + LX_SCR + 2048 + 64);
    const int g = (int)blockIdx.x % 24, rank = (int)blockIdx.x / 24, ng = (F.G - g + 23) / 24;
    const int bh = g % (BATCH * FOXH), kind = g / (BATCH * FOXH), b = bh / FOXH, h = bh % FOXH;
    const bf16* base = Z + (size_t)(b * SEQ + (lane >> 3)) * NZ + kind * 384 + h * 64 + (lane & 7) * 8;
    float m = 0.f;
#pragma unroll 4
    for (int rg = rank * NWAVES + F.wave; rg < SEQ / 8; rg += ng * NWAVES) {
        const v4u v = *(const GAS v4u*)(base + (size_t)rg * 8 * NZ);
        const unsigned w[4] = {v.x, v.y, v.z, v.w}; float ss = 0.f;
#pragma unroll
        for (int j = 0; j < 4; ++j) { const float a = bf2f(w[j] & 0xffffu), c = bf2f(w[j] >> 16); ss += a * a + c * c; }
        ss += __shfl_xor(ss, 1); ss += __shfl_xor(ss, 2); ss += __shfl_xor(ss, 4);
        m = fmaxf(m, ss);
    }
    m = fmaxf(m, __shfl_xor(m, 8)); m = fmaxf(m, __shfl_xor(m, 16)); m = fmaxf(m, __shfl_xor(m, 32));
    if (lane == 0) red[F.wave] = m;
    WG_SYNC();
    if (F.tid == 0) { float mm = red[0];
#pragma unroll
        for (int w = 1; w < NWAVES; ++w) mm = fmaxf(mm, red[w]);
        __hip_atomic_fetch_max(nrm + g, __float_as_uint(mm), RLX_AGENT); }
    WG_SYNC();
}
__device__ __forceinline__ void ph_gla1(Frame& F, const float* wa2, const float* ba) {
    const bf16* Z = (const bf16*)(F.ws + WS_Z); const float* ZF = (const float*)(F.ws + WS_ZF);
    float* KVT = (float*)(F.ws + WS_KV); float* DEC = (float*)(F.ws + WS_DEC); bf16* QIN = (bf16*)(F.ws + WS_QIN); bf16* KIN = (bf16*)(F.ws + WS_KIN);
    const int hf = F.tid >> 8, tl = F.tid & 255, wl = F.wave & 3;
    LAS unsigned char* base = F.lds + RING_OFF + hf * 40960;
    LAS float* ga = (LAS float*)base, *bcum = ga + 1024;
    LAS bf16* KOT = (LAS bf16*)(base + 16640); LAS bf16* VT = (LAS bf16*)(base + 25856);
    LAS float* WA = (LAS float*)(F.lds + RING_OFF + 81920); LAS float* BA = WA + 16 * 192;
    for (int idx = F.tid; idx < 16 * 192; idx += 512) WA[idx] = wa2[idx];
    if (F.tid < 192) BA[F.tid] = ba[F.tid];
    const int lane = F.lane, r32 = lane & 31, hi = lane >> 5;
    for (int p = blockIdx.x; p < BATCH * GLAH * NCHUNK / 2; p += F.G) {
        const int u = 2 * p + hf;
        const int bh = u / NCHUNK, n = u % NCHUNK, b = bh / GLAH, h = bh % GLAH, row0 = b * SEQ + n * GCH;
        v4u q8[2], k8[2];
#pragma unroll
        for (int k = 0; k < 2; ++k) { const int idx = tl + 256 * k; q8[k] = (v4u){0u, 0u, 0u, 0u}; k8[k] = q8[k];
            if (idx < 384) { const int qi = idx & 63, qc = idx >> 6; q8[k] = *(const GAS v4u*)(Z + (size_t)(row0 + qi) * NZ + 1152 + h * GDK + qc * 8); k8[k] = *(const GAS v4u*)(Z + (size_t)(row0 + qi) * NZ + 1344 + h * GDK + qc * 8); } }
#pragma unroll
        for (int k = 0; k < 3; ++k) { const int idx = tl + 256 * k, j = idx & 63, c12 = idx >> 6; const v4u v8 = *(const GAS v4u*)(Z + (size_t)(row0 + j) * NZ + 1536 + h * GDV + c12 * 8);
            const unsigned w[4] = {v8.x, v8.y, v8.z, v8.w};
#pragma unroll
            for (int e = 0; e < 8; ++e) VT[(c12 * 8 + e) * 72 + j] = (bf16)((w[e >> 1] >> ((e & 1) * 16)) & 0xffffu); }
#pragma unroll
        for (int k = 0; k < 4; ++k) { const int idx = tl + 256 * k, i = idx >> 4, r = idx & 15; ga[idx] = ZF[(size_t)(row0 + i) * 32 + 6 + r]; }
        WG_SYNC();
        for (int idx = tl; idx < GCH * GDK; idx += 256) { const int i = idx / GDK, d = idx % GDK; float sacc = BA[h * GDK + d];
#pragma unroll
            for (int r = 0; r < 16; ++r) sacc += ga[i * 16 + r] * WA[r * 192 + h * GDK + d];
            bcum[i * 49 + d] = log_sigmoidf(sacc) * (1.0f / 16.0f); }
        WG_SYNC();
        if (tl < GDK) { float vals[GCH];
#pragma unroll
            for (int i = 0; i < GCH; ++i) vals[i] = bcum[i * 49 + tl];
            float run = 0.f;
#pragma unroll
            for (int i = 0; i < GCH; ++i) { run += vals[i]; bcum[i * 49 + tl] = run; } }
        WG_SYNC();
#pragma unroll
        for (int k = 0; k < 2; ++k) { const int idx = tl + 256 * k;
            if (idx < 384) { const int qi = idx & 63, qc = idx >> 6; const unsigned qw[4] = {q8[k].x, q8[k].y, q8[k].z, q8[k].w}, kw[4] = {k8[k].x, k8[k].y, k8[k].z, k8[k].w}; float qo[8], ko[8];
#pragma unroll
                for (int e = 0; e < 8; ++e) { const int d = qc * 8 + e; const float bb = bcum[qi * 49 + d], eb = __expf(bb), ei = __expf(-bb);
                    qo[e] = bf2f((qw[e >> 1] >> ((e & 1) * 16)) & 0xffffu) * 0.14433756729740643f * eb; ko[e] = bf2f((kw[e >> 1] >> ((e & 1) * 16)) & 0xffffu) * ei;
                    KOT[d * 72 + qi] = (bf16)f2bf(ko[e] * __expf(bcum[63 * 49 + d])); }
                v4u o; o.x = pk2(qo[0], qo[1]); o.y = pk2(qo[2], qo[3]); o.z = pk2(qo[4], qo[5]); o.w = pk2(qo[6], qo[7]); *(GAS v4u*)(QIN + (size_t)u * 3072 + qi * GDK + qc * 8) = o;
                o.x = pk2(ko[0], ko[1]); o.y = pk2(ko[2], ko[3]); o.z = pk2(ko[4], ko[5]); o.w = pk2(ko[6], ko[7]); *(GAS v4u*)(KIN + (size_t)u * 3072 + qi * GDK + qc * 8) = o; } }
        if (tl < GDK) DEC[(size_t)u * GDK + tl] = __expf(bcum[63 * 49 + tl]);
        WG_SYNC();
#pragma unroll
        for (int tt = 0; tt < 2; ++tt) { const int tile = wl + 4 * tt;
            if (tile < 6) { const int dt = tile / 3, vt = tile % 3; f32x16 acc = {};
#pragma unroll
                for (int sx = 0; sx < 4; ++sx) { const bf16x8 a = *(const LAS bf16x8*)(KOT + (32 * dt + r32) * 72 + 16 * sx + 8 * hi), bb = *(const LAS bf16x8*)(VT + (32 * vt + r32) * 72 + 16 * sx + 8 * hi); acc = mfma32(a, bb, acc); }
                float* kv = KVT + (size_t)u * (GDK * GDV) + (size_t)(32 * vt + r32) * GDK;
#pragma unroll
                for (int q4 = 0; q4 < 4; ++q4) { const int d0 = 32 * dt + 8 * q4 + 4 * hi; if (d0 < GDK) *(f32x4*)(kv + d0) = (f32x4){acc[4 * q4], acc[4 * q4 + 1], acc[4 * q4 + 2], acc[4 * q4 + 3]}; } } }
        WG_SYNC();
    }
}
__device__ __forceinline__ void pool_unit(Frame& F, int u, const bf16* wpt, const float* ps) {
    const bf16* Z = (const bf16*)(F.ws + WS_Z); bf16* MIX = (bf16*)(F.ws + WS_MIX);
    LAS bf16* UB = (LAS bf16*)(F.lds + RING_OFF); LAS bf16* PB = (LAS bf16*)(F.lds + RING_OFF + 40448); LAS bf16* WP = (LAS bf16*)(F.lds + RING_OFF + 74240);
    const int lane = F.lane, r32 = lane & 31, hi = lane >> 5;
    {
        const int t0 = u * 64, bbase = (t0 >> 13) << 13;
        for (int idx = F.tid; idx < 79 * 32; idx += 512) { const int r = idx >> 5, c32 = idx & 31, tt = t0 - 15 + r;
            v4u val = (v4u){0u, 0u, 0u, 0u}; if (tt >= bbase) val = *(const GAS v4u*)(Z + (size_t)tt * NZ + 2304 + c32 * 8);
            *(LAS v4u*)(UB + r * 256 + c32 * 8) = val; }
        for (int idx = F.tid; idx < 2048; idx += 512) { const int gd = idx >> 3, c8 = idx & 7; *(LAS v4u*)(WP + gd * 72 + c8 * 8) = *(const GAS v4u*)(wpt + gd * 64 + c8 * 8); }
        WG_SYNC();
        { const int c = F.tid & 255, half = F.tid >> 8, g = c >> 6, w = 2 << g, i0 = half * 32; int pos = t0 - bbase + i0;
          float s = 0.f; for (int j = 1; j < w; ++j) s += bf2f(UB[(15 + i0 - j) * 256 + c]);
          for (int i = i0; i < i0 + 32; ++i, ++pos) { const float ui = bf2f(UB[(15 + i) * 256 + c]); s += ui; const int cnt = pos + 1 < w ? pos + 1 : w;
              PB[i * 264 + c] = (bf16)f2bf(s / (float)cnt - ui); s -= bf2f(UB[(15 + i - (w - 1)) * 256 + c]); } }
        WG_SYNC();
        { const int g = F.wave & 3, it = F.wave >> 2;
#pragma unroll
          for (int dt = 0; dt < 2; ++dt) { f32x16 acc = {};
#pragma unroll
              for (int s = 0; s < 4; ++s) { const bf16x8 a = *(const LAS bf16x8*)(PB + (32 * it + r32) * 264 + g * 64 + 16 * s + 8 * hi), bb = *(const LAS bf16x8*)(WP + (g * 64 + 32 * dt + r32) * 72 + 16 * s + 8 * hi); acc = mfma32(a, bb, acc); }
              const int col = g * 64 + 32 * dt + r32; const float sc = ps[col];
#pragma unroll
              for (int r = 0; r < 16; ++r) MIX[(size_t)(t0 + 32 * it + crow(r, hi)) * D + 768 + col] = (bf16)f2bf(acc[r] * sc); } }
        WG_SYNC();
    }
}
__device__ __forceinline__ void ph_glascan(Frame& F, gu32* done) {
    const float* KVT = (const float*)(F.ws + WS_KV); const float* DEC = (const float*)(F.ws + WS_DEC); bf16* ST = (bf16*)(F.ws + WS_ST);
    constexpr int NEL = BATCH * GLAH * GDK * GDV;
    for (int blk = F.G - 1 - (int)blockIdx.x; blk * 512 < NEL; blk += F.G) {
        const int gid = blk * 512 + F.tid;
        if (gid < NEL) {
            const int bh = gid / (GDK * GDV), e = gid % (GDK * GDV), d = e % GDK; float S = 0.f;
#pragma unroll 8
            for (int n = 0; n < NCHUNK; ++n) { const size_t ix = (size_t)bh * NCHUNK + n;
                __hip_atomic_store(ST + ix * (GDK * GDV) + e, (bf16)f2bf(S), __ATOMIC_RELAXED, __HIP_MEMORY_SCOPE_AGENT);
                S = S * DEC[ix * GDK + d] + KVT[ix * (GDK * GDV) + e]; } }
        WG_SYNC();
        if (F.tid == 0) __hip_atomic_fetch_add(done, 1u, RLX_AGENT);
    }
}
constexpr int NPOOLU = T / 64, NGLA3U = BATCH * GLAH * NCHUNK, NSCANBLK = (BATCH * GLAH * GDK * GDV + 511) / 512;
__device__ __forceinline__ void gla3_unit(Frame& F, int u, const float* gng) {
    const bf16* Z = (const bf16*)(F.ws + WS_Z); const bf16* ST = (const bf16*)(F.ws + WS_ST); const bf16* QIN = (const bf16*)(F.ws + WS_QIN); const bf16* KIN = (const bf16*)(F.ws + WS_KIN); bf16* MIX = (bf16*)(F.ws + WS_MIX);
    LAS bf16* QI = (LAS bf16*)(F.lds + RING_OFF); LAS bf16* KI = (LAS bf16*)(F.lds + RING_OFF + 7168); LAS bf16* VT = (LAS bf16*)(F.lds + RING_OFF + 14336); LAS bf16* STT = (LAS bf16*)(F.lds + RING_OFF + 28160);
    LAS float* OB = (LAS float*)(F.lds + RING_OFF + 38912);
    const int lane = F.lane, r32 = lane & 31, hi = lane >> 5;
    {
        const int bh = u / NCHUNK, n = u % NCHUNK, b = bh / GLAH, h = bh % GLAH, row0 = b * SEQ + n * GCH;
        if (F.tid < 384) { const int i = F.tid / 6, c6 = F.tid % 6;
            *(LAS v4u*)(QI + i * 56 + c6 * 8) = *(const GAS v4u*)(QIN + (size_t)u * 3072 + i * GDK + c6 * 8); *(LAS v4u*)(KI + i * 56 + c6 * 8) = *(const GAS v4u*)(KIN + (size_t)u * 3072 + i * GDK + c6 * 8); }
        for (int idx = F.tid; idx < 768; idx += 512) { const int j = idx & 63, c12 = idx >> 6; const v4u v8 = *(const GAS v4u*)(Z + (size_t)(row0 + j) * NZ + 1536 + h * GDV + c12 * 8);
            const unsigned w[4] = {v8.x, v8.y, v8.z, v8.w};
#pragma unroll
            for (int e = 0; e < 8; ++e) VT[(c12 * 8 + e) * 72 + j] = (bf16)((w[e >> 1] >> ((e & 1) * 16)) & 0xffffu); }
        for (int idx = F.tid; idx < 576; idx += 512) { const int v = idx / 6, c6 = idx % 6; *(LAS v4u*)(STT + v * 56 + c6 * 8) = *(const GAS v4u*)(ST + (size_t)u * (GDK * GDV) + v * GDK + c6 * 8); }
        WG_SYNC();
        if (F.wave < 6) { const int it = F.wave / 3, vt = F.wave % 3;
            bf16x8 qf[3];
#pragma unroll
            for (int s = 0; s < 3; ++s) qf[s] = *(const LAS bf16x8*)(QI + (32 * it + r32) * 56 + 16 * s + 8 * hi);
            f32x16 O = {};
            for (int jt = 0; jt <= it; ++jt) { f32x16 P = {};
#pragma unroll
                for (int s = 0; s < 3; ++s) { const bf16x8 kf = *(const LAS bf16x8*)(KI + (32 * jt + r32) * 56 + 16 * s + 8 * hi); P = mfma32(kf, qf[s], P); }
                if (jt == it) {
#pragma unroll
                    for (int r = 0; r < 16; ++r) if (crow(r, hi) > r32) P[r] = 0.f; }
                v4u pa0, pa1; pa0.x = pk2(P[0], P[1]); pa0.y = pk2(P[2], P[3]); pa0.z = pk2(P[4], P[5]); pa0.w = pk2(P[6], P[7]); pa1.x = pk2(P[8], P[9]); pa1.y = pk2(P[10], P[11]); pa1.z = pk2(P[12], P[13]); pa1.w = pk2(P[14], P[15]);
#pragma unroll
                for (int s2 = 0; s2 < 2; ++s2) { const LAS bf16* vp = VT + (32 * vt + r32) * 72 + 32 * jt + 16 * s2 + 4 * hi;
                    const u16x4 lo = *(const LAS u16x4*)vp, hh = *(const LAS u16x4*)(vp + 8);
                    const bf16x8 vb = (bf16x8){(short)lo[0], (short)lo[1], (short)lo[2], (short)lo[3], (short)hh[0], (short)hh[1], (short)hh[2], (short)hh[3]};
                    O = mfma32(__builtin_bit_cast(bf16x8, s2 ? pa1 : pa0), vb, O); } }
#pragma unroll
            for (int s = 0; s < 3; ++s) { const bf16x8 sf = *(const LAS bf16x8*)(STT + (32 * vt + r32) * 56 + 16 * s + 8 * hi); O = mfma32(qf[s], sf, O); }
#pragma unroll
            for (int r = 0; r < 16; ++r) OB[(32 * it + crow(r, hi)) * 97 + 32 * vt + r32] = O[r]; }
        WG_SYNC();
        { const int i = F.tid >> 3, part = F.tid & 7; float x[12]; float ss = 0.f;
#pragma unroll
          for (int e = 0; e < 12; ++e) { x[e] = OB[i * 97 + part * 12 + e]; ss += x[e] * x[e]; }
          ss += __shfl_xor(ss, 1); ss += __shfl_xor(ss, 2); ss += __shfl_xor(ss, 4);
          const float rstd = 1.0f / sqrtf(ss * (1.0f / GDV) + RMS_EPS);
          const GAS unsigned long long* grp = (const GAS unsigned long long*)(Z + (size_t)(row0 + i) * NZ + 1920 + h * GDV + part * 12);
          GAS unsigned long long* op = (GAS unsigned long long*)(MIX + (size_t)(row0 + i) * D + 384 + h * GDV + part * 12);
          const float* gp = gng + h * GDV + part * 12;
#pragma unroll
          for (int q = 0; q < 3; ++q) { const unsigned long long w = grp[q]; const unsigned lo = (unsigned)w, hh = (unsigned)(w >> 32);
              const float o0 = x[4 * q] * rstd * gp[4 * q] * siluf(bf2f(lo & 0xffffu)), o1 = x[4 * q + 1] * rstd * gp[4 * q + 1] * siluf(bf2f(lo >> 16));
              const float o2 = x[4 * q + 2] * rstd * gp[4 * q + 2] * siluf(bf2f(hh & 0xffffu)), o3 = x[4 * q + 3] * rstd * gp[4 * q + 3] * siluf(bf2f(hh >> 16));
              op[q] = (unsigned long long)pk2(o0, o1) | ((unsigned long long)pk2(o2, o3) << 32); } }
        WG_SYNC();
    }
}
__device__ __forceinline__ void ph_mixer_queue(Frame& F, int l, const float* const* in, char* lds_generic, const bf16* wpt, const float* ps, const float* gng) {
    gu32* q = F.ctl + CW_TAILQ + l * 64; gu32* qv = F.ctl + CW_CONVQ + l * 64; gu32* done = F.ctl + CW_SCAN + l * 64; gu32* nrm = F.ctl + CW_NRM + l * 64;
    const attn_body::bf16* Z = (const attn_body::bf16*)(F.ws + WS_Z); const float* FC = (const float*)(F.ws + WS_FCUM); attn_body::bf16* MIX = (attn_body::bf16*)(F.ws + WS_MIX);
    LAS int* slot = (LAS int*)(F.lds + LX_SCR + 2048);
    constexpr int NATT = BATCH * FOXH * 32, NCOMP = NATT + NPOOLU + NGLA3U;
    const bool has_conv = true;
    const int nstatic = F.G - (has_conv ? 128 : 0);
    bool comp_left = true, conv_left = has_conv, scan_ok = false;
    int mode = ((int)blockIdx.x >= nstatic) ? 1 : 0;
    int item = (int)blockIdx.x; unsigned nxt = 0u;
    if (mode == 0 && F.tid == 0) nxt = (unsigned)nstatic + __hip_atomic_fetch_add(q, 1u, RLX_AGENT);
    for (;;) {
        if (mode == 0) {
            if (!comp_left) { if (conv_left) { mode = 1; continue; } break; }
            if (item >= NCOMP) { comp_left = false; continue; }
            if (item < NATT) { const int qb = 31 - item / (BATCH * FOXH), bh = item % (BATCH * FOXH);
                const float q2 = __uint_as_float(__hip_atomic_load(nrm + bh, RLX_AGENT)), k2 = __uint_as_float(__hip_atomic_load(nrm + 12 + bh, RLX_AGENT));
                attn_body::attn_unit<8>(bh / FOXH, bh % FOXH, qb, Z, FC, sqrtf(q2 * k2) * 1.01f, MIX, lds_generic); }
            else if (item < NATT + NPOOLU) pool_unit(F, item - NATT, wpt, ps);
            else {
                if (!scan_ok) {
                    if (F.tid < 64) { unsigned sp = 0;
                        while ((unsigned)__builtin_amdgcn_readfirstlane(__hip_atomic_load(done, RLX_AGENT)) < (unsigned)NSCANBLK) { __builtin_amdgcn_s_sleep(2); if (++sp > (1u << 22)) break; }
                        __builtin_amdgcn_fence(__ATOMIC_ACQUIRE, "agent"); asm volatile("s_waitcnt vmcnt(0)" ::: "memory"); }
                    WG_SYNC(); scan_ok = true; }
                gla3_unit(F, item - NATT - NPOOLU, gng); }
            if (F.tid == 0) *slot = (int)nxt;
            WG_SYNC();
            item = __builtin_amdgcn_readfirstlane(*slot);
            if (F.tid == 0) nxt = (unsigned)nstatic + __hip_atomic_fetch_add(q, 1u, RLX_AGENT);
            REFRESH_F();
        } else {
            if (!conv_left) {
                if (!comp_left) break;
                mode = 0;
                if (F.tid == 0) { *slot = (int)((unsigned)nstatic + __hip_atomic_fetch_add(q, 1u, RLX_AGENT)); nxt = (unsigned)nstatic + __hip_atomic_fetch_add(q, 1u, RLX_AGENT); }
                WG_SYNC();
                item = __builtin_amdgcn_readfirstlane(*slot);
                WG_SYNC();
                continue; }
            conv_run(F, in, l, qv, slot);
            conv_left = false;
            REFRESH_F();
        }
    }
}
template <int R>
__device__ __forceinline__ void ph_ln1_router(Frame& F, int l, int cslot, const float* const* in) {
    const int gw = F.vcu * NWAVES + F.wave, NGW = F.G * NWAVES, lane = F.lane;
    const float* mod = (const float*)(F.ws + WS_MOD) + (size_t)l * 2 * 6144;
    const bf16* Xin = (const bf16*)(F.ws + WS_X0); const bf16* Y = (const bf16*)(F.ws + WS_Y); bf16* X1 = (bf16*)(F.ws + WS_X1); unsigned char* H2 = F.ws + WS_H2;
    const float* g1 = in[12] + (size_t)l * D; const float* b1 = in[13] + (size_t)l * D; const float* br = in[15] + (size_t)l * NE;
    int* TOKE = (int*)(F.ws + WS_TOKE); int* TOKS = (int*)(F.ws + WS_TOKS); float* TOKG = (float*)(F.ws + WS_TOKG); int* LIST = (int*)(F.ws + WS_LIST);
    LAS float* wrT = (LAS float*)(F.lds + RING_OFF);
    LAS int* hist = (LAS int*)(F.lds + LX_HIST); LAS int* hbase = hist + 32;
    LAS float* lsc = (LAS float*)(F.lds + LX_SCR) + F.wave * 64;
    unsigned long long xn[R][4], yn[R][4];
#define LN1_LOAD(mm) do { _Pragma("unroll") for (int rr = 0; rr < R; ++rr) { const GAS unsigned long long* xr = (const GAS unsigned long long*)(Xin + (size_t)((mm) + rr) * D) + lane; const GAS unsigned long long* yr = (const GAS unsigned long long*)(Y + (size_t)((mm) + rr) * D) + lane; \
        _Pragma("unroll") for (int j = 0; j < 4; ++j) { xn[rr][j] = __builtin_nontemporal_load((const unsigned long long*)(xr + 64 * j)); yn[rr][j] = __builtin_nontemporal_load((const unsigned long long*)(yr + 64 * j)); } } } while (0)
    if (gw * R < T) LN1_LOAD(gw * R);
    { const float* wt = (const float*)(F.ws + WS_WRT) + (size_t)l * NE * D;
      for (int idx = F.tid; idx < NE * D / 4; idx += 512) ((LAS f32x4*)wrT)[idx] = ((const f32x4*)wt)[idx];
      if (F.tid < 32) hist[F.tid] = 0; }
    WG_SYNC();
    for (int m0 = gw * R; m0 < T; m0 += NGW * R) {
        const int b = m0 >> 13; const float* mb = mod + (size_t)b * 6144;
        f32x4 v[R][4]; float mean[R], rstd[R];
#pragma unroll
        for (int rr = 0; rr < R; ++rr) {
#pragma unroll
            for (int j = 0; j < 4; ++j) { const int c0 = 256 * j + 4 * lane; const f32x4 gt = *(const f32x4*)(mb + 2048 + c0); v[rr][j] = bf4_to_f32(xn[rr][j]) * DN_ALPHA + (gt + 1.0f) * bf4_to_f32(yn[rr][j]); } }
        if (m0 + NGW * R < T) LN1_LOAD(m0 + NGW * R);
#pragma unroll
        for (int rr = 0; rr < R; ++rr) { float s = 0.f;
#pragma unroll
            for (int j = 0; j < 4; ++j) s += (v[rr][j].x + v[rr][j].y) + (v[rr][j].z + v[rr][j].w);
            mean[rr] = s; }
#pragma unroll
        for (int rr = 0; rr < R; ++rr) mean[rr] = wave_sum(mean[rr]);
#pragma unroll
        for (int rr = 0; rr < R; ++rr) { mean[rr] *= (1.f / D); float s2 = 0.f;
#pragma unroll
            for (int j = 0; j < 4; ++j) { v[rr][j] = v[rr][j] - mean[rr]; s2 += (v[rr][j].x * v[rr][j].x + v[rr][j].y * v[rr][j].y) + (v[rr][j].z * v[rr][j].z + v[rr][j].w * v[rr][j].w); }
            rstd[rr] = s2; }
#pragma unroll
        for (int rr = 0; rr < R; ++rr) rstd[rr] = wave_sum(rstd[rr]);
#pragma unroll
        for (int rr = 0; rr < R; ++rr) { rstd[rr] = 1.f / sqrtf(rstd[rr] * (1.f / D) + LN_EPS);
            GAS unsigned long long* x1r = (GAS unsigned long long*)(X1 + (size_t)(m0 + rr) * D) + lane;
            GAS unsigned* o4 = (GAS unsigned*)(H2 + (size_t)(m0 + rr) * D) + lane;
#pragma unroll
            for (int j = 0; j < 4; ++j) { const int c0 = 256 * j + 4 * lane;
                const f32x4 x1 = v[rr][j] * rstd[rr] * *(const f32x4*)(g1 + c0) + *(const f32x4*)(b1 + c0);
                __builtin_nontemporal_store(f32_to_bf4(x1), (unsigned long long*)(x1r + 64 * j));
                const f32x4 h = x1 * (*(const f32x4*)(mb + 4096 + c0) + 1.0f) + *(const f32x4*)(mb + 3072 + c0);
                v[rr][j] = h;
                o4[64 * j] = pg8::pk4_fp8(h.x, h.y, h.z, h.w); } }
        float p[R][32];
#pragma unroll
        for (int e = 0; e < 32; ++e) {
#pragma unroll
            for (int rr = 0; rr < R; ++rr) p[rr][e] = 0.f;
#pragma unroll
            for (int j = 0; j < 4; ++j) { const f32x4 w = *(const LAS f32x4*)(wrT + e * D + 256 * j + 4 * lane);
#pragma unroll
                for (int rr = 0; rr < R; ++rr) p[rr][e] += (v[rr][j].x * w.x + v[rr][j].y * w.y) + (v[rr][j].z * w.z + v[rr][j].w * w.w); } }
#define DPPF(v, ctrl) __builtin_bit_cast(float, __builtin_amdgcn_update_dpp(0, __builtin_bit_cast(int, (v)), (ctrl), 0xf, 0xf, false))
#pragma unroll
        for (int rr = 0; rr < R; ++rr) {
#pragma unroll
            for (int i = 0; i < 16; ++i) { auto r2 = __builtin_amdgcn_permlane32_swap(__float_as_uint(p[rr][i]), __float_as_uint(p[rr][i + 16]), false, false); p[rr][i] = __uint_as_float(r2[0]) + __uint_as_float(r2[1]); }
#pragma unroll
            for (int i = 0; i < 8; ++i) { auto r2 = __builtin_amdgcn_permlane16_swap(__float_as_uint(p[rr][i]), __float_as_uint(p[rr][i + 8]), false, false); p[rr][i] = __uint_as_float(r2[0]) + __uint_as_float(r2[1]); }
#pragma unroll
            for (int i = 0; i < 4; ++i) { const bool up = (lane & 8) != 0; const float keep = up ? p[rr][i + 4] : p[rr][i], send = up ? p[rr][i] : p[rr][i + 4]; p[rr][i] = keep + DPPF(send, 0x128  ); }
#pragma unroll
            for (int i = 0; i < 2; ++i) { const bool up = (lane & 4) != 0; const float keep = up ? p[rr][i + 2] : p[rr][i], send = up ? p[rr][i] : p[rr][i + 2]; p[rr][i] = keep + __shfl_xor(send, 4); }
            { const bool up = (lane & 2) != 0; const float keep = up ? p[rr][1] : p[rr][0], send = up ? p[rr][0] : p[rr][1]; p[rr][0] = keep + DPPF(send, 0x4E  ); }
            p[rr][0] += DPPF(p[rr][0], 0xB1  );
        }
#pragma unroll
        for (int rr = 0; rr < R; ++rr) {
            const int m = m0 + rr;
            if ((lane & 1) == 0) lsc[lane >> 1] = p[rr][0] + br[lane >> 1];
            LDS_WAIT(); asm volatile("" ::: "memory");
            const int me = lane & 31; const float my = lsc[me]; int rank = 0;
#pragma unroll
            for (int e4 = 0; e4 < 8; ++e4) { const f32x4 q4 = *(const LAS f32x4*)(lsc + 4 * e4);
#pragma unroll
                for (int j = 0; j < 4; ++j) { const int e = 4 * e4 + j; rank += (q4[j] > my || (q4[j] == my && e < me)) ? 1 : 0; } }
            if (lane < 32 && rank < 4) { lsc[32 + rank] = my; ((LAS int*)lsc)[36 + rank] = me; }
            LDS_WAIT(); asm volatile("" ::: "memory");
            const f32x4 sv = *(const LAS f32x4*)(lsc + 32);
            const float e1 = __expf(sv[1] - sv[0]), e2 = __expf(sv[2] - sv[0]), e3 = __expf(sv[3] - sv[0]); const float inv = 1.0f / (1.0f + e1 + e2 + e3);
            if (lane < 4) { const int e = ((LAS int*)lsc)[36 + lane]; const float gte = (lane == 0 ? 1.0f : lane == 1 ? e1 : lane == 2 ? e2 : e3) * inv;
                const int rnk = atomicAdd((int*)(hist + e), 1);
                TOKE[(size_t)m * 4 + lane] = e; TOKS[(size_t)m * 4 + lane] = rnk; TOKG[(size_t)m * 4 + lane] = gte; }
            LDS_WAIT(); asm volatile("" ::: "memory");
        }
#undef DPPF
    }
    WG_SYNC();
    if (F.tid < 32) hbase[F.tid] = (int)__hip_atomic_fetch_add((unsigned*)(F.ctl + CW_CNT + (cslot * 32 + F.tid) * 64), (unsigned)hist[F.tid], RLX_AGENT);
    WG_SYNC();
    for (int m0 = gw * R; m0 < T; m0 += NGW * R) { if (lane < 4 * R) { const size_t q = (size_t)m0 * 4 + lane; const int e = TOKE[q], slot = TOKS[q] + hbase[e]; TOKS[q] = slot; LIST[e * 16384 + slot] = m0 + (lane >> 2); } }
#undef LN1_LOAD
}
__device__ __forceinline__ int moe_tables(Frame& F, int l) {
    LAS int* tab = (LAS int*)(F.lds + LX_TAB); LAS int* pst = (LAS int*)(F.lds + LX_PST); LAS int* cntl = (LAS int*)(F.lds + LX_CNT);
    if (F.tid < NE) cntl[F.tid] = (int)__hip_atomic_load((unsigned*)(F.ctl + CW_CNT + (l * 32 + F.tid) * 64), RLX_AGENT);
    WG_SYNC();
    if (F.tid == 0) { int run = 0;
#pragma unroll 1
        for (int e = 0; e < NE; ++e) { const int c = cntl[e]; const int nt = (c + 255) >> 8;
            pst[e] = run * 256; for (int k = 0; k < nt; ++k) tab[run + k] = e; run += nt; }
        pst[NE] = run; }
    WG_SYNC();
    return pst[NE];
}
template <int R>
__device__ __forceinline__ void ph_ln2(Frame& F, int l, float* xout, const float* const* in) {
    if (!MK_ONE_LAUNCH) (void)moe_tables(F, l);
    LAS int* pst = (LAS int*)(F.lds + LX_PST);
    const int gw = F.vcu * NWAVES + F.wave, NGW = F.G * NWAVES, lane = F.lane;
    const float* mod = (const float*)(F.ws + WS_MOD) + (size_t)l * 2 * 6144;
    const bf16* X1 = (const bf16*)(F.ws + WS_X1); bf16* X0 = (bf16*)(F.ws + WS_X0); bf16* H = (bf16*)(F.ws + WS_H); const bf16* YR = (const bf16*)(F.ws + WS_YROWS);
    const float* g2 = in[20] + (size_t)l * D; const float* b2 = in[21] + (size_t)l * D;
    const int* TOKE = (const int*)(F.ws + WS_TOKE); const int* TOKS = (const int*)(F.ws + WS_TOKS); const float* TOKG = (const float*)(F.ws + WS_TOKG);
    int rowA[R][4], rowB[R][4]; float gkA[R][4], gkB[R][4]; unsigned long long yd[R][4][4]; unsigned long long xd[R][4];
#define LN2_IDX(mm, ROW, GK) do { _Pragma("unroll") for (int rr = 0; rr < R; ++rr) _Pragma("unroll") for (int k = 0; k < 4; ++k) { const size_t q = (size_t)((mm) + rr) * 4 + k; ROW[rr][k] = pst[TOKE[q]] + TOKS[q]; GK[rr][k] = TOKG[q]; } } while (0)
#define LN2_DATA(mm, ROW) do { _Pragma("unroll") for (int rr = 0; rr < R; ++rr) { _Pragma("unroll") for (int k = 0; k < 4; ++k) { const GAS unsigned long long* yr = (const GAS unsigned long long*)(YR + (size_t)ROW[rr][k] * D) + lane; \
            _Pragma("unroll") for (int j = 0; j < 4; ++j) yd[rr][k][j] = __builtin_nontemporal_load((const unsigned long long*)(yr + 64 * j)); } \
        const GAS unsigned long long* xr = (const GAS unsigned long long*)(X1 + (size_t)((mm) + rr) * D) + lane; _Pragma("unroll") for (int j = 0; j < 4; ++j) xd[rr][j] = __builtin_nontemporal_load((const unsigned long long*)(xr + 64 * j)); } } while (0)
    const int mstep = NGW * R;
    if (gw * R < T) { LN2_IDX(gw * R, rowA, gkA); LN2_DATA(gw * R, rowA); }
    if (gw * R + mstep < T) LN2_IDX(gw * R + mstep, rowB, gkB);
    for (int m0 = gw * R; m0 < T; m0 += mstep) {
        const int b = m0 >> 13; const float* mb = mod + (size_t)b * 6144;
        f32x4 v[R][4]; float mean[R], rstd[R];
#pragma unroll
        for (int rr = 0; rr < R; ++rr) {
            f32x4 y[4];
#pragma unroll
            for (int j = 0; j < 4; ++j) y[j] = (f32x4){0.f, 0.f, 0.f, 0.f};
#pragma unroll
            for (int k = 0; k < 4; ++k) { const float g = gkA[rr][k];
#pragma unroll
                for (int j = 0; j < 4; ++j) { const unsigned long long w = yd[rr][k][j]; const unsigned lo = (unsigned)w, hi = (unsigned)(w >> 32);
                    y[j].x += g * bf2f(lo & 0xffffu); y[j].y += g * bf2f(lo >> 16); y[j].z += g * bf2f(hi & 0xffffu); y[j].w += g * bf2f(hi >> 16); } }
            float s = 0.f;
#pragma unroll
            for (int j = 0; j < 4; ++j) { const int c0 = 256 * j + 4 * lane; const f32x4 gt = *(const f32x4*)(mb + 5120 + c0);
                v[rr][j] = bf4_to_f32(xd[rr][j]) * DN_ALPHA + (gt + 1.0f) * y[j]; s += (v[rr][j].x + v[rr][j].y) + (v[rr][j].z + v[rr][j].w); }
            mean[rr] = s; }
#pragma unroll
        for (int rr = 0; rr < R; ++rr)
#pragma unroll
            for (int k = 0; k < 4; ++k) { rowA[rr][k] = rowB[rr][k]; gkA[rr][k] = gkB[rr][k]; }
        if (m0 + mstep < T) LN2_DATA(m0 + mstep, rowA);
        if (m0 + 2 * mstep < T) LN2_IDX(m0 + 2 * mstep, rowB, gkB);
#pragma unroll
        for (int rr = 0; rr < R; ++rr) mean[rr] = wave_sum(mean[rr]);
#pragma unroll
        for (int rr = 0; rr < R; ++rr) { mean[rr] *= (1.f / D); float s2 = 0.f;
#pragma unroll
            for (int j = 0; j < 4; ++j) { v[rr][j] = v[rr][j] - mean[rr]; s2 += (v[rr][j].x * v[rr][j].x + v[rr][j].y * v[rr][j].y) + (v[rr][j].z * v[rr][j].z + v[rr][j].w * v[rr][j].w); }
            rstd[rr] = s2; }
#pragma unroll
        for (int rr = 0; rr < R; ++rr) rstd[rr] = wave_sum(rstd[rr]);
        const float* mn = mod + 2 * 6144 + (size_t)b * 6144;
#pragma unroll
        for (int rr = 0; rr < R; ++rr) { rstd[rr] = 1.f / sqrtf(rstd[rr] * (1.f / D) + LN_EPS);
            GAS f32x4* xo = (GAS f32x4*)(xout + (size_t)(m0 + rr) * D) + lane; GAS unsigned long long* xb = (GAS unsigned long long*)(X0 + (size_t)(m0 + rr) * D) + lane;
            GAS unsigned long long* o8 = (GAS unsigned long long*)(H + (size_t)(m0 + rr) * D) + lane;
#pragma unroll
            for (int j = 0; j < 4; ++j) { const int c0 = 256 * j + 4 * lane;
                const f32x4 x = v[rr][j] * rstd[rr] * *(const f32x4*)(g2 + c0) + *(const f32x4*)(b2 + c0);
                if (l + 1 == DEPTH) xo[64 * j] = x; else __builtin_nontemporal_store(f32_to_bf4(x), (unsigned long long*)(xb + 64 * j));
                if (l + 1 < DEPTH) { const f32x4 h = x * (*(const f32x4*)(mn + 1024 + c0) + 1.0f) + *(const f32x4*)(mn + c0);
                    o8[64 * j] = (unsigned long long)pk2(h.x, h.y) | ((unsigned long long)pk2(h.z, h.w) << 32); } } }
    }
#undef LN2_IDX
#undef LN2_DATA
}

constexpr int PH_CONV = 0, PH_MODFIN = 1, PH_MOD0 = 2, PH_L0 = 3, PH_PER_LAYER = 7, NPH = PH_L0 + DEPTH * PH_PER_LAYER;
struct Args { const float* in[22]; float* out; unsigned char* ws; int ph_lo, ph_hi; };
__global__ void __launch_bounds__(NWAVES * 64, 2) fwd_kernel(Args args) {
    extern __shared__ __attribute__((aligned(16))) unsigned char lds[];
    Frame F;
    F.lds = (LAS unsigned char*)lds;
    F.MISC = (volatile LAS unsigned*)(F.lds + MISC_OFF);
    F.tid = threadIdx.x; F.lane = F.tid & 63; F.wave = __builtin_amdgcn_readfirstlane(F.tid >> 6);
    F.G = gridDim.x; { const int bx = blockIdx.x; F.vcu = (F.G % 8 == 0) ? (bx % 8) * (F.G / 8) + bx / 8 : bx; }
    F.ws = args.ws; F.ctl = (gu32*)(args.ws + WS_CTL);
    for (int u = F.tid; u < (LDS_BYTES - LDSCTL_OFF) / 4; u += NWAVES * 64) ((LAS unsigned*)(F.lds + LDSCTL_OFF))[u] = 0u;
    __syncthreads();
    XcdBarrier bar; bar.bar = (unsigned*)(F.ctl + CW_BAR); bar.x = 0; bar.st = nullptr;
    if (MK_ONE_LAUNCH) bar = xcd_barrier_post((unsigned*)(F.ctl + CW_BAR), F.MISC + 8);
    const int lo = args.ph_lo, hi = args.ph_hi;
#define IN(k) (lo <= (k) && (k) < hi)
#ifndef PROBE_DUP
#define PROBE_DUP 0
#endif
#define REP(k) _Pragma("unroll 1") for (int rep_ = 0; rep_ < (((PROBE_DUP >> (k)) & 1) ? 2 : 1); ++rep_)
#define REFRESH() do { F.tid = opaque_tid(); F.lane = F.tid & 63; F.wave = __builtin_amdgcn_readfirstlane(F.tid >> 6); } while (0)
#define SEAM(k) do { if (MK_ONE_LAUNCH && IN(k) && IN((k) + 1)) xcd_barrier(bar); } while (0)
    const float* const* in = args.in;

    if (IN(PH_CONV)) {
#ifndef NO_CONV
 REP(10) { REFRESH(); ph_convert(F, in); }
#endif
 } SEAM(PH_CONV);
    if (IN(PH_MODFIN)) { REFRESH(); ph_modfin(F, in); } SEAM(PH_MODFIN);
    if (IN(PH_MOD0)) { REFRESH(); ph_mod0(F, in[0]); } SEAM(PH_MOD0);

    for (int l = 0; l < DEPTH; ++l) {
        const int pb = PH_L0 + l * PH_PER_LAYER;
        float* xout = args.out;
        if (IN(pb + 0)) {
#ifndef NO_G0
 REP(0) {            pg8::Gemm g{(const pg8::bf16_t*)(F.ws + WS_H), (const pg8::bf16_t*)(F.ws + WS_WIN) + (size_t)l * NINP * D, T, NINP, D};
            pg8::StaticOrder S; S.init(T, NINP, F.G, (int)blockIdx.x);
            pg8::EpiZ E{(pg8::bf16_t*)(F.ws + WS_Z), (float*)(F.ws + WS_ZF), (const float*)(F.ws + WS_BINP) + (size_t)l * NINP, (float*)(F.ws + WS_LF)};
            pg8::gemm_phase<pg8::EpiZ, pg8::StaticOrder, true, false>(F.lds + RING_OFF, g, S, E); }
#endif
        } SEAM(pb + 0);
        if (IN(pb + 1)) {
#ifndef NO_PRE
            REFRESH(); ph_fcum(F);
            REFRESH(); ph_qknorm(F, F.ctl + CW_NRM + l * 64);
            REFRESH(); ph_gla1(F, in[6] + (size_t)l * 16 * 192, in[7] + (size_t)l * 192);
#endif
        } SEAM(pb + 1);
        if (IN(pb + 2)) {
#ifndef NO_ATT
            REFRESH(); ph_glascan(F, F.ctl + CW_SCAN + l * 64);
            REFRESH(); ph_mixer_queue(F, l, in, (char*)lds + RING_OFF, (const bf16*)(F.ws + WS_WPT) + (size_t)l * 4 * 64 * 64, in[10] + (size_t)l * 256, in[8] + (size_t)l * 384);
#endif
        } SEAM(pb + 2);
        if (IN(pb + 3)) {
#ifndef NO_G4
 REP(4) {            pg8::Gemm g{(const pg8::bf16_t*)(F.ws + WS_MIX), (const pg8::bf16_t*)(F.ws + WS_WOUT) + (size_t)l * D * D, T, D, D};
            pg8::StaticOrder S; S.init(T, D, F.G, (int)blockIdx.x);
            pg8::EpiY E{(pg8::bf16_t*)(F.ws + WS_Y)};
            pg8::gemm_phase<pg8::EpiY, pg8::StaticOrder, true, false>(F.lds + RING_OFF, g, S, E); }
#endif
        } SEAM(pb + 3);
        if (IN(pb + 4)) {
#ifndef NO_LN1
 REP(5) { REFRESH(); ph_ln1_router<2>(F, l, (rep_ + 1 < (((PROBE_DUP >> 5) & 1) ? 2 : 1)) ? l + 4 : l, in); }
#endif
 } SEAM(pb + 4);
        if (IN(pb + 5)) {
#if !defined(NO_G7)
            REFRESH(); const int Mt = __builtin_amdgcn_readfirstlane(moe_tables(F, l));
            unsigned* rdy = (unsigned*)(F.ctl + CW_RDY + l * (320 * 64));
            { pg8::Gemm g{(const pg8::bf16_t*)(F.ws + WS_H2), (const pg8::bf16_t*)(F.ws + WS_WGU + (size_t)l * NE * 2048 * D), MROWS, 2048, D / 2};
              pg8::MoeOrder<8, 1> S{(const LAS int*)(F.lds + LX_TAB), (const LAS int*)(F.lds + LX_PST), (const LAS int*)(F.lds + LX_CNT), (const int*)(F.ws + WS_LIST), Mt, F.G, (int)blockIdx.x, rdy, 0};
              pg8::EpiSwiglu E{F.ws + WS_ACT, in[17] + (size_t)l * NE * 2048};
              pg8::gemm_phase<pg8::EpiSwiglu, pg8::MoeOrder<8, 1>, true, true, true>(F.lds + RING_OFF, g, S, E, 0x7a7a7a7a); }
            { REFRESH();
              const int extra = (Mt * 8) % F.G;
              const int xsh = (((Mt + 7) >> 3) * 2) & 7;
              pg8::Gemm g{(const pg8::bf16_t*)(F.ws + WS_ACT), (const pg8::bf16_t*)(F.ws + WS_WDN + (size_t)l * NE * D * D), MROWS, D, D / 2};
              pg8::MoeOrder<4, 2> S{(const LAS int*)(F.lds + LX_TAB), (const LAS int*)(F.lds + LX_PST), (const LAS int*)(F.lds + LX_CNT), (const int*)(F.ws + WS_LIST), Mt, F.G, F.G == 256 ? (int)blockIdx.x : ((int)blockIdx.x - extra + F.G) % F.G, rdy, xsh};
              pg8::EpiDown E{(pg8::bf16_t*)(F.ws + WS_YROWS), in[19] + (size_t)l * NE * D};
              pg8::gemm_phase<pg8::EpiDown, pg8::MoeOrder<4, 2>, true, false, true>(F.lds + RING_OFF, g, S, E, 0x79797979); }
#endif
        } SEAM(pb + 5);
        if (IN(pb + 6)) {
#ifndef NO_LN2
 REP(9) { REFRESH(); ph_ln2<1>(F, l, xout, in); }
#endif
 } SEAM(pb + 6);
    }
#undef IN
#undef SEAM
}

extern "C" void kernel_launch(void* const* d_in, const int* in_sizes, int n_in, void* d_out, int out_size, void* d_ws, size_t ws_size, hipStream_t stream) {
    static int grid = 0;
    if (grid == 0) {
        if (n_in != 22 || in_sizes[0] != T * D || out_size != T * D || ws_size < WS_END) { fprintf(stderr, "kernel_launch: unexpected shapes (n_in %d, in0 %d, out %d, ws %zu)\n", n_in, n_in > 0 ? in_sizes[0] : -1, out_size, ws_size); grid = -1; return; }
        int dev = 0, cus = 0, per_cu = 0;
        if (hipGetDevice(&dev) != hipSuccess || hipDeviceGetAttribute(&cus, hipDeviceAttributeMultiprocessorCount, dev) != hipSuccess) { grid = -1; return; }
        if (hipFuncSetAttribute((const void*)fwd_kernel, hipFuncAttributeMaxDynamicSharedMemorySize, LDS_BYTES) != hipSuccess) { fprintf(stderr, "kernel_launch: hipFuncSetAttribute failed\n"); grid = -1; return; }
        if (hipOccupancyMaxActiveBlocksPerMultiprocessor(&per_cu, (const void*)fwd_kernel, NWAVES * 64, LDS_BYTES) != hipSuccess || per_cu < 1) fprintf(stderr, "kernel_launch: occupancy query reports %d\n", per_cu);
        (void)hipGetLastError();
        grid = cus;
    }
    if (grid < 0) return;
    if (hipMemsetAsync((char*)d_ws + WS_CTL, 0, CTL_ZERO_BYTES, stream) != hipSuccess) return;
    Args a{};
    for (int i = 0; i < 22; ++i) a.in[i] = (const float*)d_in[i];
    a.out = (float*)d_out; a.ws = (unsigned char*)d_ws;
#if MK_ONE_LAUNCH
    a.ph_lo = 0; a.ph_hi = NPH;
    hipLaunchKernelGGL(fwd_kernel, dim3(grid), dim3(NWAVES * 64), LDS_BYTES, stream, a);
#else
    for (int p = 0; p < NPH; ++p) { a.ph_lo = p; a.ph_hi = p + 1; hipLaunchKernelGGL(fwd_kernel, dim3(grid), dim3(NWAVES * 64), LDS_BYTES, stream, a); }
#endif
}
```

```cpp
#include <hip/hip_runtime.h>
#include <hip/hip_bf16.h>
#include <cstdio>
#include <cstdint>
#include <cmath>
__device__ __forceinline__ int opaque_tid() { int t = threadIdx.x; asm volatile("" : "+v"(t)); return t; }
#ifndef MK_ONE_LAUNCH
#define MK_ONE_LAUNCH 1
#endif
namespace pg8 {
#define PG8_LAS __attribute__((address_space(3)))
typedef unsigned short bf16_t;
typedef short bf16x8 __attribute__((ext_vector_type(8)));
typedef float f32x4 __attribute__((ext_vector_type(4)));
typedef unsigned u32x4 __attribute__((ext_vector_type(4)));
typedef unsigned u32x2 __attribute__((ext_vector_type(2)));
typedef int i32x8 __attribute__((ext_vector_type(8)));
typedef int i32x4 __attribute__((ext_vector_type(4)));
__device__ __forceinline__ unsigned pk4_fp8(float a, float b, float c, float d) { int r = __builtin_amdgcn_cvt_pk_fp8_f32(a, b, 0, false); r = __builtin_amdgcn_cvt_pk_fp8_f32(c, d, r, true); return (unsigned)r; }
constexpr int TOKL_OFF = 137664;
constexpr int BM = 256, BK = 64, HALF = 128, HTB = HALF * BK * 2  , STAGE_BYTES = 8 * HTB, NXCD = 8, WGM = 8;

__host__ __device__ __forceinline__ int lds_byte(int r, int c) { const int st = (r >> 4) * 2 + (c >> 5), rr = r & 15, cc = c & 31, ob = rr * 64 + cc * 2; return st * 1024 + (ob ^ (((ob >> 9) & 1) << 5)); }
__host__ __device__ __forceinline__ void stage_rc(int b, int& R, int& C) { const int st = b / 1024, sb = b % 1024, swz = sb ^ (((sb >> 9) & 1) << 5); R = (st >> 1) * 16 + swz / 64; C = (st & 1) * 32 + (swz % 64) / 2; }
__host__ __device__ __forceinline__ int perm32(int rho) { const int n = rho >> 4, i = rho & 15; return 8 * (i >> 2) + 4 * n + (i & 3); }

struct Unit { int pm, pn; };
struct Gemm { const bf16_t* A; const bf16_t* Bt; int M, N, K; };

struct StaticOrder {
    int nM, nN, nwg, G, c;
    __host__ __device__ void init(int M, int N, int G_, int c_) { nM = M / BM; nN = N / BM; nwg = nM * nN; G = G_; c = c_; }
    __host__ __device__ bool next(int i, Unit& u) const {
        const long L = (long)i * G + c; if (L >= nwg) return false;
        int wgid = (int)L; { const int q = nwg / NXCD, r = nwg % NXCD, xcd = wgid % NXCD, off = wgid / NXCD; wgid = (xcd < r ? xcd * (q + 1) : r * (q + 1) + (xcd - r) * q) + off; }
        const int nig = WGM * nN, gid = wgid / nig, fm = gid * WGM, gsz = (nM - fm) < WGM ? (nM - fm) : WGM;
        u.pm = fm + ((wgid % nig) % gsz); u.pn = (wgid % nig) / gsz; return true;
    }
    __device__ __forceinline__ unsigned peek(const Unit&) const { return 0u; }
    __device__ __forceinline__ void a_ready(const Unit&, unsigned = 0u) const {}
    __device__ __forceinline__ void done(const Unit&) const {}
    __device__ __forceinline__ void publish(int) const {}
};

__device__ __forceinline__ unsigned cvt_pk_bf16(float lo, float hi) { unsigned r; asm volatile("v_cvt_pk_bf16_f32 %0, %1, %2" : "=v"(r) : "v"(lo), "v"(hi)); return r; }
typedef float f32x2 __attribute__((ext_vector_type(2)));
struct EpiF32 {
    static constexpr bool PERM = false, AFTER_DRAIN = false;
    float* C; int ldc; const float* bias;
    __device__ __forceinline__ void operator()(const f32x4 (&acc)[2][2][4][2], const Unit& u, int wr, int wc, int fr, int fq) const {
        const int row0 = u.pm * BM + wr * 64 + fr, col0 = u.pn * BM + wc * 32 + 4 * fq;
        f32x4 bv[2][2];
#pragma unroll
        for (int bj = 0; bj < 2; ++bj)
#pragma unroll
            for (int n = 0; n < 2; ++n) bv[bj][n] = bias ? *(const f32x4*)(bias + col0 + bj * HALF + n * 16) : (f32x4){0.f, 0.f, 0.f, 0.f};
#pragma unroll
        for (int ai = 0; ai < 2; ++ai)
#pragma unroll
            for (int m = 0; m < 4; ++m) { float* rowp = C + (size_t)(row0 + ai * HALF + m * 16) * ldc + col0;
#pragma unroll
                for (int bj = 0; bj < 2; ++bj)
#pragma unroll
                    for (int n = 0; n < 2; ++n) *(f32x4*)(rowp + bj * HALF + n * 16) = acc[ai][bj][m][n] + bv[bj][n]; }
    }
};
struct EpiY {
    static constexpr bool PERM = true, AFTER_DRAIN = false;
    bf16_t* Y;
    __device__ __forceinline__ void operator()(const f32x4 (&acc)[2][2][4][2], const Unit& u, int wr, int wc, int fr, int fq) const {
        const int row0 = u.pm * BM + wr * 64 + fr, col0 = u.pn * BM + wc * 32 + 8 * fq;
#pragma unroll
        for (int ai = 0; ai < 2; ++ai)
#pragma unroll
            for (int m = 0; m < 4; ++m) { bf16_t* rowp = Y + (size_t)(row0 + ai * HALF + m * 16) * 1024 + col0;
#pragma unroll
                for (int bj = 0; bj < 2; ++bj) { const f32x4 v0 = acc[ai][bj][m][0], v1 = acc[ai][bj][m][1];
                    u32x4 w; w.x = cvt_pk_bf16(v0[0], v0[1]); w.y = cvt_pk_bf16(v0[2], v0[3]); w.z = cvt_pk_bf16(v1[0], v1[1]); w.w = cvt_pk_bf16(v1[2], v1[3]);
                    *(u32x4*)(rowp + bj * HALF) = w; } }
    }
};
struct EpiZ {
    static constexpr bool PERM = true, AFTER_DRAIN = false;
    bf16_t* Z; float* ZF; const float* bias; float* LF;
    __device__ __forceinline__ void operator()(const f32x4 (&acc)[2][2][4][2], const Unit& u, int wr, int wc, int fr, int fq) const {
        const int row0 = u.pm * BM + wr * 64 + fr;
        if (u.pn < 10) {
            const int col0 = u.pn * BM + wc * 32 + 8 * fq;
            f32x4 bv[2][2];
#pragma unroll
            for (int bj = 0; bj < 2; ++bj)
#pragma unroll
                for (int n = 0; n < 2; ++n) bv[bj][n] = *(const f32x4*)(bias + col0 + bj * HALF + 4 * n);
#pragma unroll
            for (int ai = 0; ai < 2; ++ai)
#pragma unroll
                for (int m = 0; m < 4; ++m) { bf16_t* rowp = Z + (size_t)(row0 + ai * HALF + m * 16) * 2560 + col0;
#pragma unroll
                    for (int bj = 0; bj < 2; ++bj) { const f32x4 v0 = acc[ai][bj][m][0] + bv[bj][0], v1 = acc[ai][bj][m][1] + bv[bj][1];
                        u32x4 w; w.x = cvt_pk_bf16(v0[0], v0[1]); w.y = cvt_pk_bf16(v0[2], v0[3]); w.z = cvt_pk_bf16(v1[0], v1[1]); w.w = cvt_pk_bf16(v1[2], v1[3]);
                        *(u32x4*)(rowp + bj * HALF) = w; } }
        } else if (wc == 0) {
            const f32x4 b0 = *(const f32x4*)(bias + 2560 + 8 * fq), b1 = *(const f32x4*)(bias + 2560 + 8 * fq + 4);
#pragma unroll
            for (int ai = 0; ai < 2; ++ai)
#pragma unroll
                for (int m = 0; m < 4; ++m) { const int row = row0 + ai * HALF + m * 16; float* rp = ZF + (size_t)row * 32 + 8 * fq;
                    const f32x4 z0 = acc[ai][0][m][0] + b0, z1 = acc[ai][0][m][1] + b1;
                    *(f32x4*)rp = z0; *(f32x4*)(rp + 4) = z1;
                    if (fq == 0) { float* lf = LF + (size_t)(row >> 13) * 6 * 8192 + (row & 8191);
#define EPIZ_LS(x) (fminf((x), 0.f) - __logf(1.0f + __expf(-fabsf(x))))
                        lf[0] = EPIZ_LS(z0[0]); lf[8192] = EPIZ_LS(z0[1]); lf[2 * 8192] = EPIZ_LS(z0[2]); lf[3 * 8192] = EPIZ_LS(z0[3]); lf[4 * 8192] = EPIZ_LS(z1[0]); lf[5 * 8192] = EPIZ_LS(z1[1]);
#undef EPIZ_LS
                    } }
        }
    }
};
struct EpiSwiglu {
    static constexpr bool PERM = true, AFTER_DRAIN = false;
    unsigned char* ACT; const float* bgu;
    __device__ __forceinline__ void operator()(const f32x4 (&acc)[2][2][4][2], const Unit& u, int wr, int wc, int fr, int fq) const {
        const int e = u.pn >> 3, pnl = u.pn & 7;
        const int row0 = u.pm * BM + wr * 64 + fr, col0 = pnl * 128 + wc * 32 + 8 * fq;
        const float* bg = bgu + (size_t)e * 2048 + col0;
        const f32x4 bg0 = *(const f32x4*)bg, bg1 = *(const f32x4*)(bg + 4), bl0 = *(const f32x4*)(bg + 1024), bl1 = *(const f32x4*)(bg + 1028);
#pragma unroll
        for (int ai = 0; ai < 2; ++ai)
#pragma unroll
            for (int m = 0; m < 4; ++m) {
                f32x4 g0 = acc[ai][0][m][0] + bg0, g1 = acc[ai][0][m][1] + bg1, l0 = acc[ai][1][m][0] + bl0, l1 = acc[ai][1][m][1] + bl1;
                float o[8];
#pragma unroll
                for (int j = 0; j < 4; ++j) {
                    float g = fminf(g0[j], 7.0f), l = fminf(fmaxf(l0[j], -7.0f), 7.0f);
                    o[j] = g * __builtin_amdgcn_rcpf(1.0f + __expf(-1.702f * g)) * (l + 1.0f);
                    g = fminf(g1[j], 7.0f); l = fminf(fmaxf(l1[j], -7.0f), 7.0f);
                    o[4 + j] = g * __builtin_amdgcn_rcpf(1.0f + __expf(-1.702f * g)) * (l + 1.0f);
                }
                u32x2 w; w.x = pk4_fp8(o[0], o[1], o[2], o[3]); w.y = pk4_fp8(o[4], o[5], o[6], o[7]);
                __hip_atomic_store((unsigned long long*)(ACT + (size_t)(row0 + ai * HALF + m * 16) * 1024 + col0), (unsigned long long)w.x | ((unsigned long long)w.y << 32), __ATOMIC_RELAXED, __HIP_MEMORY_SCOPE_AGENT);
            }
    }
};
struct EpiDown {
    static constexpr bool PERM = true, AFTER_DRAIN = false;
    bf16_t* Y; const float* bdn;
    __device__ __forceinline__ void operator()(const f32x4 (&acc)[2][2][4][2], const Unit& u, int wr, int wc, int fr, int fq) const {
        const int e = u.pn >> 2, pnl = u.pn & 3;
        const int row0 = u.pm * BM + wr * 64 + fr, col0 = pnl * BM + wc * 32 + 8 * fq;
        f32x4 bv[2][2];
#pragma unroll
        for (int bj = 0; bj < 2; ++bj)
#pragma unroll
            for (int n = 0; n < 2; ++n) bv[bj][n] = *(const f32x4*)(bdn + (size_t)e * 1024 + col0 + bj * HALF + 4 * n);
#pragma unroll
        for (int ai = 0; ai < 2; ++ai)
#pragma unroll
            for (int m = 0; m < 4; ++m) { bf16_t* rowp = Y + (size_t)(row0 + ai * HALF + m * 16) * 1024 + col0;
#pragma unroll
                for (int bj = 0; bj < 2; ++bj) { const f32x4 v0 = acc[ai][bj][m][0] + bv[bj][0], v1 = acc[ai][bj][m][1] + bv[bj][1];
                    u32x4 w; w.x = cvt_pk_bf16(v0[0], v0[1]); w.y = cvt_pk_bf16(v0[2], v0[3]); w.z = cvt_pk_bf16(v1[0], v1[1]); w.w = cvt_pk_bf16(v1[2], v1[3]);
                    *(u32x4*)(rowp + bj * HALF) = w; } }
    }
};
template <int NN, int ROLE = 0> struct MoeOrder {
    const PG8_LAS int* tab; const PG8_LAS int* pst; const PG8_LAS int* cnt; const int* list; int Mt, G, c;
    unsigned* ready;
    int xs;
    __device__ __forceinline__ bool next(int i, Unit& u) const {
        int mt, pnl;
        if (G == 256) { const int x = ((c & 7) - xs) & 7, j = c >> 3, NG = (Mt + 7) >> 3, st = i * 8 + x;
            if (st >= NG * (NN / 4)) return false;
            const int gm = (NN == 8) ? (st >> 1) : st, nh = (NN == 8) ? (st & 1) : 0; mt = gm * 8 + (j & 7); if (mt >= Mt) mt = Mt - 1; pnl = nh * 4 + (j >> 3); }
        else { const int L = i * G + c; if (L >= Mt * NN) return false; mt = L / NN; pnl = L % NN; }
        u.pm = mt; u.pn = __builtin_amdgcn_readfirstlane(tab[mt]) * NN + pnl; return true;
    }
    __device__ __forceinline__ const int* row_addr(const Unit& u, int r) const {
        const int e = __builtin_amdgcn_readfirstlane(tab[u.pm]); const int idx = u.pm * 256 - pst[e] + r, c = cnt[e];
        return list + e * 16384 + (idx < c ? idx : c - 1);
    }
    __device__ __forceinline__ int row_token(const Unit& u, int r) const {
        const int e = __builtin_amdgcn_readfirstlane(tab[u.pm]); const int idx = u.pm * 256 - pst[e] + r, c = cnt[e];
        return list[e * 16384 + (idx < c ? idx : c - 1)];
    }
    __device__ __forceinline__ unsigned peek(const Unit& u) const {
        if constexpr (ROLE == 2) { if (threadIdx.x < 64) return __hip_atomic_load(ready + 64 * u.pm, __ATOMIC_RELAXED, __HIP_MEMORY_SCOPE_AGENT); }
        return 0u;
    }
    __device__ __forceinline__ void a_ready(const Unit& u, unsigned early = 0u) const {
        if constexpr (ROLE == 2) {
            if (threadIdx.x < 64) { unsigned sp = 0;
                if ((unsigned)__builtin_amdgcn_readfirstlane(early) < 64u)
                while ((unsigned)__builtin_amdgcn_readfirstlane(__hip_atomic_load(ready + 64 * u.pm, __ATOMIC_RELAXED, __HIP_MEMORY_SCOPE_AGENT)) < 64u) { __builtin_amdgcn_s_sleep(2); if (++sp > (1u << 22)) break; }
                __builtin_amdgcn_fence(__ATOMIC_ACQUIRE, "agent");
                asm volatile("s_waitcnt vmcnt(0)" ::: "memory"); }
            asm volatile("" ::: "memory"); __builtin_amdgcn_s_barrier(); asm volatile("" ::: "memory");
        }
    }
    __device__ __forceinline__ void done(const Unit&) const {}
    __device__ __forceinline__ void publish(int pm) const {
        if constexpr (ROLE == 1) { if (pm >= 0 && (threadIdx.x & 63) == 0) __hip_atomic_fetch_add(ready + 64 * pm, 1u, __ATOMIC_RELAXED, __HIP_MEMORY_SCOPE_AGENT); }
    }
};

template <class Epi, class Sched, bool ALIGN_EPI = false, bool GATHER = false, bool FP8 = false>
__device__ __forceinline__ void gemm_phase(PG8_LAS unsigned char* lds, const Gemm g, const Sched& S, const Epi& E, const int scale_w = 0x7f7f7f7f) {
    const int tid = opaque_tid(), wid = __builtin_amdgcn_readfirstlane(tid >> 6), lane = tid & 63, wr = wid >> 2, wc = wid & 3, fr = lane & 15, fq = lane >> 4;
    const int K = g.K, nt = K / BK;
    const unsigned kstep = (unsigned)(BK * 2);
    const unsigned hstep = (unsigned)HALF * K * 2;
    const unsigned tstep = 2 * hstep;
    const __amdgpu_buffer_rsrc_t rsrcA = __builtin_amdgcn_make_buffer_rsrc((void*)g.A, 0, 0x7fffffff, 0x00020000), rsrcB = __builtin_amdgcn_make_buffer_rsrc((void*)g.Bt, 0, 0x7fffffff, 0x00020000);
    unsigned vAc[2][2], vAn[2][2], voffB[2]; int sR[2], sC[2];
#pragma unroll
    for (int i = 0; i < 2; ++i) { int R, C; stage_rc(tid * 16 + i * 8192, R, C); const int Rb = Epi::PERM ? ((R & ~31) + perm32(R & 31)) : R; sR[i] = R; sC[i] = C;
        voffB[i] = (unsigned)(Rb * K + C) * 2u;
#pragma unroll
        for (int h = 0; h < 2; ++h) { vAc[h][i] = (unsigned)(R * K + C) * 2u + (unsigned)(h * hstep); vAn[h][i] = vAc[h][i]; } }
    const unsigned ldsw = (unsigned)wid * 1024u;
    const int aoff = lds_byte(wr * 64 + fr, fq * 8), boff = lds_byte(wc * 32 + fr, fq * 8);
#define PG8_SA(b, h) (((b) * 2 + (h)) * HTB)
#define PG8_SB(b, h) ((4 + (b) * 2 + (h)) * HTB)
#define PG8_STAGE_(bufoff, rsrc, soff, voff) do { _Pragma("unroll") for (int _i = 0; _i < 2; ++_i) \
        __builtin_amdgcn_raw_ptr_buffer_load_lds(rsrc, (PG8_LAS void*)(lds + (bufoff) + ldsw + _i * 8192), 16, (voff)[_i], (soff), 0, 0); } while (0)
#define PG8_STAGE_A(bufoff, soff, voff) PG8_STAGE_(bufoff, rsrcA, soff, voff)
#define PG8_STAGE_B(bufoff, soff, voff) PG8_STAGE_(bufoff, rsrcB, soff, voff)
#define PG8_LDA(dst, b, h) do { _Pragma("unroll") for (int m = 0; m < 4; ++m) _Pragma("unroll") for (int k = 0; k < 2; ++k) dst[m][k] = *(const PG8_LAS bf16x8*)(lds + PG8_SA(b, h) + aoff + m * 2048 + k * 1024); } while (0)
#define PG8_LDB(dst, b, h) do { _Pragma("unroll") for (int n = 0; n < 2; ++n) _Pragma("unroll") for (int k = 0; k < 2; ++k) dst[n][k] = *(const PG8_LAS bf16x8*)(lds + PG8_SB(b, h) + boff + n * 2048 + k * 1024); } while (0)
#define PG8_CAT(x) __builtin_shufflevector(__builtin_bit_cast(i32x4, (x)[0]), __builtin_bit_cast(i32x4, (x)[1]), 0, 1, 2, 3, 4, 5, 6, 7)
#define PG8_MMA(ai, bj, At, Bt) do { __builtin_amdgcn_s_setprio(1); _Pragma("unroll") for (int m = 0; m < 4; ++m) _Pragma("unroll") for (int n = 0; n < 2; ++n) { \
        if constexpr (FP8) { asm("v_mfma_scale_f32_16x16x128_f8f6f4 %0, %1, %2, %0, %3, %4 op_sel_hi:[0,0,0]" : "+v"(acc[ai][bj][m][n]) : "v"(PG8_CAT(Bt[n])), "v"(PG8_CAT(At[m])), "v"(scale_w), "v"(sone)); } \
        else { _Pragma("unroll") for (int k = 0; k < 2; ++k) acc[ai][bj][m][n] = __builtin_amdgcn_mfma_f32_16x16x32_bf16(Bt[n][k], At[m][k], acc[ai][bj][m][n], 0, 0, 0); } } __builtin_amdgcn_s_setprio(0); } while (0)
#define PG8_WAIT_V(n) asm volatile("s_waitcnt vmcnt(" #n ")" ::: "memory")
#define PG8_WAIT_L(n) asm volatile("s_waitcnt lgkmcnt(" #n ")" ::: "memory")
#define PG8_BAR __builtin_amdgcn_s_barrier()
#define PG8_SCHED __builtin_amdgcn_sched_barrier(0)
    unsigned early = 0u;
    const PG8_LAS int* tokl = (const PG8_LAS int*)(lds + TOKL_OFF) + wid * 256;
    const unsigned tokl_base = (unsigned)__builtin_amdgcn_readfirstlane((int)(unsigned)(uintptr_t)(lds + TOKL_OFF) + wid * 1024);
    Unit cur, nxt; int ui = 0; int pend = -1;
    if (!S.next(0, cur)) return;
    const int sone = 0x7f7f7f7f;
    f32x4 acc[2][2][4][2];
#pragma unroll
    for (int a = 0; a < 2; ++a)
#pragma unroll
        for (int b = 0; b < 2; ++b)
#pragma unroll
            for (int m = 0; m < 4; ++m)
#pragma unroll
                for (int n = 0; n < 2; ++n) acc[a][b][m][n] = (f32x4){0.f, 0.f, 0.f, 0.f};
    bf16x8 At[4][2], B0[2][2], B1[2][2];
    unsigned cA = GATHER ? 0u : (unsigned)cur.pm * tstep, cB = (unsigned)cur.pn * tstep;
    if constexpr (GATHER) {
#pragma unroll
        for (int h = 0; h < 2; ++h)
#pragma unroll
            for (int i = 0; i < 2; ++i) { vAc[h][i] = (unsigned)(S.row_token(cur, h * HALF + sR[i]) * K + sC[i]) * 2u; vAn[h][i] = vAc[h][i]; }
    }
    S.a_ready(cur);
    PG8_STAGE_B(PG8_SB(0, 0), cB, voffB); PG8_STAGE_B(PG8_SB(0, 1), cB + hstep, voffB); PG8_STAGE_A(PG8_SA(0, 0), cA, vAc[0]); PG8_STAGE_A(PG8_SA(0, 1), cA, vAc[1]);
    if (wr == 1) PG8_BAR;
    PG8_WAIT_V(2); PG8_BAR;
    PG8_STAGE_B(PG8_SB(1, 0), cB + kstep, voffB); PG8_STAGE_A(PG8_SA(1, 0), cA + kstep, vAc[0]); PG8_STAGE_B(PG8_SB(1, 1), cB + hstep + kstep, voffB);
    PG8_WAIT_V(6); PG8_BAR;
    for (;;) {
        const bool has_next = S.next(ui + 1, nxt);
        const unsigned nA = (has_next && !GATHER) ? (unsigned)nxt.pm * tstep : cA, nB = has_next ? (unsigned)nxt.pn * tstep : cB;
#pragma unroll 1
        for (int t = 0; t < nt; t += 2) {
            const bool last = (t == nt - 2);
            if (t == nt - 4 && has_next) early = S.peek(nxt);
            if constexpr (GATHER) {
                if (t == nt - 4 && has_next) {
#pragma unroll
                    for (int h = 0; h < 2; ++h)
#pragma unroll
                        for (int i = 0; i < 2; ++i) { const int* ga_ = S.row_addr(nxt, h * HALF + sR[i]); unsigned keep_;
                            asm volatile("s_mov_b32 %0, m0\n\ts_mov_b32 m0, %2\n\ts_nop 0\n\tglobal_load_lds_dword %1, off\n\ts_mov_b32 m0, %0" : "=&s"(keep_) : "v"(ga_), "s"(tokl_base + (unsigned)((h * 2 + i) * 256)) : "memory"); } }
                if (last && has_next) {
#pragma unroll
                    for (int h = 0; h < 2; ++h)
#pragma unroll
                        for (int i = 0; i < 2; ++i) vAn[h][i] = (unsigned)(tokl[(h * 2 + i) * 64 + lane] * K + sC[i]) * 2u; } }
            unsigned vA2[2][2];
#pragma unroll
            for (int h = 0; h < 2; ++h)
#pragma unroll
                for (int i = 0; i < 2; ++i) vA2[h][i] = last ? vAn[h][i] : vAc[h][i];
            const unsigned a1 = cA + (unsigned)(t + 1) * kstep;
            const unsigned a2 = last ? nA : cA + (unsigned)(t + 2) * kstep, b2 = last ? nB : cB + (unsigned)(t + 2) * kstep;
            const unsigned a3 = a2 + kstep, b3 = b2 + kstep;
            if (last && has_next) S.a_ready(nxt, early);
            PG8_LDB(B0, 0, 0); PG8_LDB(B1, 0, 1); PG8_SCHED; PG8_LDA(At, 0, 0); PG8_STAGE_A(PG8_SA(1, 1), a1, vAc[1]);
            PG8_WAIT_V(8); PG8_WAIT_L(0); PG8_BAR; PG8_MMA(0, 0, At, B0); PG8_MMA(0, 1, At, B1); PG8_BAR; PG8_SCHED;
            PG8_LDA(At, 0, 1); PG8_STAGE_B(PG8_SB(0, 0), b2, voffB); PG8_STAGE_B(PG8_SB(0, 1), b2 + hstep, voffB); PG8_STAGE_A(PG8_SA(0, 0), a2, vA2[0]);
            PG8_WAIT_V(8); PG8_WAIT_L(0); PG8_BAR; PG8_MMA(1, 0, At, B0); PG8_MMA(1, 1, At, B1); PG8_BAR; PG8_SCHED;
            PG8_LDB(B0, 1, 0); PG8_LDB(B1, 1, 1); PG8_SCHED; PG8_LDA(At, 1, 0); PG8_STAGE_A(PG8_SA(0, 1), a2, vA2[1]);
            PG8_WAIT_V(8); PG8_WAIT_L(0); PG8_BAR; PG8_MMA(0, 0, At, B0); PG8_MMA(0, 1, At, B1); PG8_BAR; PG8_SCHED;
            PG8_LDA(At, 1, 1); PG8_STAGE_B(PG8_SB(1, 0), b3, voffB); PG8_STAGE_B(PG8_SB(1, 1), b3 + hstep, voffB); PG8_STAGE_A(PG8_SA(1, 0), a3, vA2[0]);
            PG8_WAIT_V(8); PG8_WAIT_L(0); PG8_BAR; PG8_MMA(1, 0, At, B0); PG8_MMA(1, 1, At, B1); PG8_BAR; PG8_SCHED;
        }
        if constexpr (ALIGN_EPI) { if (wr == 0) PG8_BAR; }
        if constexpr (FP8) asm volatile("s_nop 15\n\ts_nop 15" ::: "memory");
        S.publish(pend); E(acc, cur, wr, wc, fr, fq); S.done(cur); pend = cur.pm;
        if (!has_next) break;
#pragma unroll
        for (int a = 0; a < 2; ++a)
#pragma unroll
            for (int b = 0; b < 2; ++b)
#pragma unroll
                for (int m = 0; m < 4; ++m)
#pragma unroll
                    for (int n = 0; n < 2; ++n) acc[a][b][m][n] = (f32x4){0.f, 0.f, 0.f, 0.f};
        cur = nxt; cA = nA; cB = nB; ++ui;
#pragma unroll
        for (int h = 0; h < 2; ++h)
#pragma unroll
            for (int i = 0; i < 2; ++i) vAc[h][i] = vAn[h][i];
        if constexpr (ALIGN_EPI) { if (wr == 1) PG8_BAR; }
    }
    PG8_WAIT_V(0);
    S.publish(pend);
    if constexpr (!ALIGN_EPI) { if (wr == 0) PG8_BAR; }
    PG8_BAR;
#undef PG8_SA
#undef PG8_SB
#undef PG8_STAGE_
#undef PG8_STAGE_A
#undef PG8_STAGE_B
#undef PG8_LDA
#undef PG8_LDB
#undef PG8_MMA
#undef PG8_CAT
#undef PG8_WAIT_V
#undef PG8_WAIT_L
#undef PG8_BAR
#undef PG8_SCHED
}
}
namespace attn_body {
using bf16=__hip_bfloat16;
using bf16x8=__attribute__((ext_vector_type(8)))short;
using s16x4=__attribute__((ext_vector_type(4)))short;
using f32x16=__attribute__((ext_vector_type(16)))float;
using u32x4=__attribute__((ext_vector_type(4)))unsigned;
constexpr int SEQ=8192,D=64,NHEAD=6;
constexpr int ZP=2560;
constexpr int OP=1024;
constexpr int NW=8,QBLK=32,QB=QBLK*NW,KVBLK=64,NQB=SEQ/QB;
__device__ __forceinline__ int crow(int r,int hi){return (r&3)+8*(r>>2)+4*hi;}
#define SBAR() __builtin_amdgcn_sched_barrier(0)
__device__ __forceinline__ void cmask(f32x16&p0,f32x16&p1,int jb,int qrel,int hi){
  const float NEG=-INFINITY; int kb=64*jb+4*hi;
  #pragma unroll
  for(int r=0;r<16;++r){int kv=kb+(r&3)+8*(r>>2); if(kv>qrel)p0[r]=NEG; if(kv+32>qrel)p1[r]=NEG;}
}
constexpr int NSLOT=3, SLOTB=8192;
constexpr int LDS_K=0, LDS_V=NSLOT*SLOTB, LDS_WS=2*NSLOT*SLOTB, LDS_OST=LDS_WS+NW*64*4, LDS_FS=LDS_OST+NW*4096, LDS_BYTES=LDS_FS+NW*512;
constexpr float C2=0.125f*1.4426950408889634f;
constexpr float LOG2E=1.4426950408889634f;
__device__ __forceinline__ void glds16(const void*gsrc,unsigned lds_dst){unsigned keep;
  asm volatile("s_mov_b32 %0, m0\n\ts_mov_b32 m0, %2\n\ts_nop 0\n\tglobal_load_lds_dwordx4 %1, off\n\ts_mov_b32 m0, %0":"=&s"(keep):"v"(gsrc),"s"(lds_dst):"memory");}
__device__ __forceinline__ void glds4(const void*gsrc,unsigned lds_dst){unsigned keep;
  asm volatile("s_mov_b32 %0, m0\n\ts_mov_b32 m0, %2\n\ts_nop 0\n\tglobal_load_lds_dword %1, off\n\ts_mov_b32 m0, %0":"=&s"(keep):"v"(gsrc),"s"(lds_dst):"memory");}
__device__ __forceinline__ float max3f(float a,float b,float c){float r;asm("v_max3_f32 %0, %1, %2, %3":"=v"(r):"v"(a),"v"(b),"v"(c));return r;}
__device__ __forceinline__ float max2f(float a,float b){float r;asm("v_max_f32_e32 %0, %1, %2":"=v"(r):"v"(a),"v"(b));return r;}
__device__ __forceinline__ float fadd_s(float a,float b){float r;asm("v_add_f32_e32 %0, %1, %2":"=v"(r):"v"(a),"v"(b));return r;}
__device__ __forceinline__ float fsub_s(float a,float b){float r;asm("v_sub_f32_e32 %0, %1, %2":"=v"(r):"v"(a),"v"(b));return r;}
typedef float f32x2_t __attribute__((ext_vector_type(2))); typedef __bf16 bf16x2_t __attribute__((ext_vector_type(2)));
__device__ __forceinline__ unsigned cvtpk_s(float lo,float hi){f32x2_t v={lo,hi};bf16x2_t b=__builtin_convertvector(v,bf16x2_t);return __builtin_bit_cast(unsigned,b);}
#define WAIT_BAR(N) asm volatile("s_waitcnt vmcnt(" #N ") lgkmcnt(0)\n\ts_barrier":::"memory")
typedef __attribute__((address_space(3))) const char* lds_cptr;
typedef short v4i16_t __attribute__((ext_vector_type(4)));
__device__ __forceinline__ void kload8(bf16x8*kf,lds_cptr kp){
  kf[0]=*(const __attribute__((address_space(3))) bf16x8*)(kp);      kf[1]=*(const __attribute__((address_space(3))) bf16x8*)(kp+512);
  kf[2]=*(const __attribute__((address_space(3))) bf16x8*)(kp+2048); kf[3]=*(const __attribute__((address_space(3))) bf16x8*)(kp+2560);
  kf[4]=*(const __attribute__((address_space(3))) bf16x8*)(kp+4096); kf[5]=*(const __attribute__((address_space(3))) bf16x8*)(kp+4608);
  kf[6]=*(const __attribute__((address_space(3))) bf16x8*)(kp+6144); kf[7]=*(const __attribute__((address_space(3))) bf16x8*)(kp+6656);
}
__device__ __forceinline__ void kload2(bf16x8*kf,lds_cptr kp,int j){ kf[2*j]=*(const __attribute__((address_space(3))) bf16x8*)(kp+j*2048); kf[2*j+1]=*(const __attribute__((address_space(3))) bf16x8*)(kp+j*2048+512); }
__device__ __forceinline__ s16x4 vtr(lds_cptr p){ return __builtin_bit_cast(s16x4,__builtin_amdgcn_ds_read_tr16_b64_v4i16((__attribute__((address_space(3))) v4i16_t*)p)); }
__device__ __forceinline__ float rowmax(const f32x16&p0,const f32x16&p1){
  float a=max3f(p0[0],p0[1],p1[0]),b=max3f(p0[2],p0[3],p1[1]);a=max3f(a,p1[2],p1[3]);
  #pragma unroll
  for(int r=4;r<16;r+=4){a=max3f(a,p0[r],p0[r+1]);b=max3f(b,p0[r+2],p0[r+3]);a=max3f(a,p1[r],p1[r+1]);b=max3f(b,p1[r+2],p1[r+3]);}
  const float m=max2f(a,b);
  auto rr=__builtin_amdgcn_permlane32_swap(__float_as_uint(m),__float_as_uint(m),false,false);
  return max2f(__uint_as_float(rr[0]),__uint_as_float(rr[1]));
}
__device__ __forceinline__ void pv(f32x16*o,int vb,bf16x8 pa0,bf16x8 pa1,bf16x8 pa2,bf16x8 pa3){
  #pragma unroll
  for(int d0=0;d0<2;++d0){s16x4 lo[4],hi[4];
    #pragma unroll
    for(int ks=0;ks<4;++ks){
      asm volatile("ds_read_b64_tr_b16 %0,%1 offset:%c2":"=&v"(lo[ks]):"v"(vb),"i"(d0*4096+ks*1024):"memory");
      asm volatile("ds_read_b64_tr_b16 %0,%1 offset:%c2":"=&v"(hi[ks]):"v"(vb),"i"(d0*4096+ks*1024+512):"memory");}
    asm volatile("s_waitcnt lgkmcnt(0)":::"memory");SBAR();
    #define PK(k) (bf16x8){lo[k][0],lo[k][1],lo[k][2],lo[k][3],hi[k][0],hi[k][1],hi[k][2],hi[k][3]}
    o[d0]=__builtin_amdgcn_mfma_f32_32x32x16_bf16(pa0,PK(0),o[d0],0,0,0);
    o[d0]=__builtin_amdgcn_mfma_f32_32x32x16_bf16(pa1,PK(1),o[d0],0,0,0);
    o[d0]=__builtin_amdgcn_mfma_f32_32x32x16_bf16(pa2,PK(2),o[d0],0,0,0);
    o[d0]=__builtin_amdgcn_mfma_f32_32x32x16_bf16(pa3,PK(3),o[d0],0,0,0);
    #undef PK
  }
}
#define AUGM(a,b) __builtin_amdgcn_mfma_f32_32x32x2f32((a),(b),(f32x16){},0,0,0)
template<int THRL> __device__ __forceinline__ void attn_unit(int b,int h,int qb,const bf16*__restrict__ Z,const float*__restrict__ F,const float qkb,bf16*O,char*shm){
  const int tid=opaque_tid(),lane=tid&63,r32=lane&31,hi=lane>>5; const int wid=__builtin_amdgcn_readfirstlane(tid>>6);
  const long rowbase=(long)b*SEQ; const int q0=qb*QB;
  const bf16*Qw=Z+(rowbase+q0+wid*QBLK)*ZP+h*D;
  const float*Fh0=F+(long)(b*NHEAD+h)*SEQ; const float Fref=Fh0[q0]; const int NTfull=(q0+QB)/KVBLK;
  int t0;
  { const float th=-(150.0f+2.0f*qkb+4.0f); int cntt=0;
    #pragma unroll
    for(int k=0;k<2;++k){ const int tt=lane+1+64*k; const bool inr=(tt<=NTfull-4); const bool c=inr&&((Fref-Fh0[(inr?tt:1)*KVBLK-1])*LOG2E<=th); cntt+=__builtin_popcountll(__ballot(c)); }
    t0=(cntt<NTfull-4?cntt:NTfull-4)&~1; t0=__builtin_amdgcn_readfirstlane(t0); }
  const bf16*Kh=Z+(rowbase+(long)t0*KVBLK)*ZP+384+h*D,*Vh=Z+(rowbase+(long)t0*KVBLK)*ZP+768+h*D;
  const float*Fh=Fh0+t0*KVBLK;
  const unsigned lds0=(unsigned)(uintptr_t)shm;
  float*wsf=(float*)(shm+LDS_WS)+wid*64;
  const bf16*ksrc=Kh+(long)lane*ZP+wid*8;
  const bf16*vsrc=Vh+(long)(16*(wid&3)+(lane>>2))*ZP+(wid>>2)*32+(lane&3)*8;
  const unsigned kdst=lds0+LDS_K+wid*1024, vdst=lds0+LDS_V+wid*1024;
  #define DMA_K(t,slot) glds16(ksrc+(long)(t)*KVBLK*ZP,(unsigned)__builtin_amdgcn_readfirstlane(kdst+(slot)))
  #define DMA_V(t,slot) glds16(vsrc+(long)(t)*KVBLK*ZP,(unsigned)__builtin_amdgcn_readfirstlane(vdst+(slot)))
  const int vb0=(int)(lds0+LDS_V)+((lane>>4)&1)*32+(lane&3)*8+(4*hi+((lane&15)>>2))*64;
  bf16x8 kf[8];
  const lds_cptr shm3=(lds_cptr)shm; const lds_cptr kp0=shm3+LDS_K+hi*1024+r32*16; const lds_cptr vp0=shm3+LDS_V+((lane>>4)&1)*32+(lane&3)*8+(4*hi+((lane&15)>>2))*64;
  const int NT=NTfull-t0;
  const float*Fl=Fh+r32;
  const float*fsl=(const float*)(shm+LDS_FS)+wid*128;
  const unsigned fdst=lds0+LDS_FS+wid*512;
  #define FLOAD(tau) glds4(Fh+(long)(tau)*KVBLK+lane,(unsigned)__builtin_amdgcn_readfirstlane(fdst+((tau)&1)*256))
  const float f0a=Fl[0],f0b=Fl[32],f1a=Fl[64],f1b=Fl[96],f0l=Fh[63],f1l=Fh[127];
  DMA_K(0,0);DMA_V(0,0);DMA_K(1,SLOTB);
  bf16x8 qr[4];
  #pragma unroll
  for(int d0=0;d0<4;++d0)qr[d0]=*reinterpret_cast<const bf16x8*>(&Qw[(long)r32*ZP+d0*16+hi*8]);
  float mhat=0.f,l_reg=0.f;f32x16 o[2];o[0]=f32x16{};o[1]=f32x16{};
  const int qrel=wid*QBLK+r32;
  float a0=hi?1.0f:(Fref-f0a)*LOG2E, a1=hi?1.0f:(Fref-f0b)*LOG2E, bq=hi?0.0f:1.0f;
  float fs=1.0f;
  float Flast=f0l;
  #define CMASK(P0,P1,t) do{int jb_=(t)-(NT-4); if(jb_>=0)cmask(P0,P1,jb_,qrel,hi);}while(0)
  bool resc=false;
  #define START(P0,P1) do{ const float rm=rowmax(P0,P1); resc=false; \
    { const float dl=rm; mhat=fadd_s(mhat,dl); \
      _Pragma("unroll") for(int r=0;r<16;++r){P0[r]=fsub_s(P0[r],dl);P1[r]=fsub_s(P1[r],dl);} } \
    _Pragma("unroll") for(int r=0;r<16;++r)P0[r]=__builtin_amdgcn_exp2f(P0[r]); }while(0)
  #define RESC() do{ if(resc){ asm volatile("s_waitcnt lgkmcnt(0)":::"memory"); \
      _Pragma("unroll") for(int d_=0;d_<2;++d_) _Pragma("unroll") for(int r=0;r<16;++r)o[d_][r]*=wsf[crow(r,hi)]; } \
      _Pragma("unroll") for(int d_=0;d_<2;++d_) _Pragma("unroll") for(int r=0;r<16;++r)o[d_][r]*=fs; }while(0)
  #define NEXTB(tn,FA,FB,FL) do{ const float fl_=(FL); \
      const float db_=((tn)<NT-4)?(Flast-fl_)*LOG2E:0.f; Flast=fl_; mhat+=db_; fs=__builtin_amdgcn_exp2f(-db_); bq=hi?-mhat:1.0f; \
      a0=hi?1.0f:(Fref-(FA))*LOG2E; a1=hi?1.0f:(Fref-(FB))*LOG2E; }while(0)
  #define NEXTL(tn) do{ const float*fp_=fsl+((tn)&1)*64; NEXTB(tn,fp_[r32],fp_[32+r32],fp_[63]); }while(0)
  f32x16 pA0,pA1,pB0,pB1;
  int sl_prev=0,sl_cur=0,sl_next=SLOTB;
  #define ROT() do{sl_prev=sl_cur;sl_cur=sl_next;sl_next=(sl_next==(NSLOT-1)*SLOTB)?0:sl_next+SLOTB;}while(0)
  DMA_K(2,2*SLOTB);
  WAIT_BAR(3);
  { const char*kb=(shm+LDS_K)+hi*1024+r32*16;
    pA0=AUGM(a0,bq); pA1=AUGM(a1,bq);
    #pragma unroll
    for(int d0=0;d0<4;++d0){ const bf16x8 b0=*reinterpret_cast<const bf16x8*>(kb+d0*2048); const bf16x8 b1=*reinterpret_cast<const bf16x8*>(kb+d0*2048+512);
      pA0=__builtin_amdgcn_mfma_f32_32x32x16_bf16(b0,qr[d0],pA0,0,0,0); pA1=__builtin_amdgcn_mfma_f32_32x32x16_bf16(b1,qr[d0],pA1,0,0,0); } }
  asm volatile("s_nop 15\n\ts_nop 7":"+v"(pA0),"+v"(pA1));CMASK(pA0,pA1,0);
  START(pA0,pA1);
  _Pragma("unroll") for(int r=0;r<16;++r)pA1[r]=__builtin_amdgcn_exp2f(pA1[r]);
  WAIT_BAR(0);
  DMA_K(3,0);DMA_V(1,SLOTB);
  FLOAD(2);
  ROT();
  kload8(kf,kp0+sl_cur);
  NEXTB(1,f1a,f1b,f1l);
  WAIT_BAR(3);
  s16x4 vlo[8],vhi[8]; u32x4 pw0,pw1,pw2,pw3;
  #define PKW(P,B) cvtpk_s(P[B],P[B+1])
  #define PAF(k) __builtin_bit_cast(bf16x8,pw##k)
  #define VFR(i) (bf16x8){vlo[i][0],vlo[i][1],vlo[i][2],vlo[i][3],vhi[i][0],vhi[i][1],vhi[i][2],vhi[i][3]}
  #define PIN(x) asm volatile("":"+v"(x))
  #define MX3(a,b,c) __builtin_fmaxf(__builtin_fmaxf((a),(b)),(c))
  #define GAPA(MF,A0,A1,A2,A3,W0,W1,PW) do{ MF; sacc+=A0; sacc+=A1; sacc+=A2; sacc+=A3; PIN(sacc); W0; W1; PIN(PW); SBAR(); }while(0)
  #define EX(v) __builtin_amdgcn_exp2f(v)
  #define GAPB(MF,X,B) do{ MF; X[B]=EX(X[B]); X[B+1]=EX(X[B+1]); X[B+2]=EX(X[B+2]); X[B+3]=EX(X[B+3]); PIN(X); SBAR(); }while(0)
  #define VRD(i) do{ vlo[i]=vtr(vp_+(((i)>>2)*4096+((i)&3)*1024)); vhi[i]=vtr(vp_+(((i)>>2)*4096+((i)&3)*1024+512)); }while(0)
  #define KRD(G,j) do{ if(G){ kload2(kf,kp0+sl_next,j); SBAR(); } }while(0)
  #define STEP(C0,C1,P0,P1,t,GK,GV,GL,GF) do{ SBAR(); \
    const lds_cptr vp_=vp0+sl_prev; \
    C0=AUGM(a0,bq); C1=AUGM(a1,bq); SBAR(); \
    VRD(0); SBAR(); float sacc=(P0[0]+P0[1]); \
    GAPA(C0=__builtin_amdgcn_mfma_f32_32x32x16_bf16(kf[0],qr[0],C0,0,0,0), P0[2],P0[3],P0[4],P0[5],     pw0[0]=PKW(P0,0), pw0[1]=PKW(P0,2), pw0); \
    VRD(4); SBAR(); GAPA(C1=__builtin_amdgcn_mfma_f32_32x32x16_bf16(kf[1],qr[0],C1,0,0,0), P0[6],P0[7],P0[8],P0[9],     pw0[2]=PKW(P0,4), pw0[3]=PKW(P0,6), pw0); \
    VRD(1); SBAR(); GAPA(C0=__builtin_amdgcn_mfma_f32_32x32x16_bf16(kf[2],qr[1],C0,0,0,0),   P0[10],P0[11],P0[12],P0[13], pw1[0]=PKW(P0,8), pw1[1]=PKW(P0,10), pw1); \
    VRD(5); SBAR(); GAPA(C1=__builtin_amdgcn_mfma_f32_32x32x16_bf16(kf[3],qr[1],C1,0,0,0),   P0[14],P0[15],P1[0],P1[1],   pw1[2]=PKW(P0,12),pw1[3]=PKW(P0,14), pw1); \
    VRD(2); SBAR(); GAPA(C0=__builtin_amdgcn_mfma_f32_32x32x16_bf16(kf[4],qr[2],C0,0,0,0),   P1[2],P1[3],P1[4],P1[5],     pw2[0]=PKW(P1,0), pw2[1]=PKW(P1,2), pw2); \
    VRD(6); SBAR(); GAPA(C1=__builtin_amdgcn_mfma_f32_32x32x16_bf16(kf[5],qr[2],C1,0,0,0),   P1[6],P1[7],P1[8],P1[9],     pw2[2]=PKW(P1,4), pw2[3]=PKW(P1,6), pw2); \
    VRD(3); SBAR(); GAPA(C0=__builtin_amdgcn_mfma_f32_32x32x16_bf16(kf[6],qr[3],C0,0,0,0),   P1[10],P1[11],P1[12],P1[13], pw3[0]=PKW(P1,8), pw3[1]=PKW(P1,10), pw3); \
    VRD(7); SBAR(); GAPA(C1=__builtin_amdgcn_mfma_f32_32x32x16_bf16(kf[7],qr[3],C1,0,0,0),   P1[14],P1[15],0.f,0.f,       pw3[2]=PKW(P1,12),pw3[3]=PKW(P1,14), pw3); \
    l_reg+=sacc; l_reg*=fs; \
    if(GK){DMA_K((t)+3,sl_cur);} if(GV){DMA_V((t)+1,sl_next);} if(GF){FLOAD((t)+2);} \
    CMASK(C0,C1,t); \
    { float a=MX3(C0[0],C0[1],C1[0]),b=MX3(C0[2],C0[3],C1[1]); a=MX3(a,C1[2],C1[3]); \
      _Pragma("unroll") for(int r=4;r<16;r+=4){a=MX3(a,C0[r],C0[r+1]);b=MX3(b,C0[r+2],C0[r+3]);a=MX3(a,C1[r],C1[r+1]);b=MX3(b,C1[r+2],C1[r+3]);} \
      float rm=__builtin_fmaxf(a,b); { auto rr=__builtin_amdgcn_permlane32_swap(__float_as_uint(rm),__float_as_uint(rm),false,false); rm=__builtin_fmaxf(__uint_as_float(rr[0]),__uint_as_float(rr[1])); } \
      resc=false; \
      if(__builtin_expect(__any(rm>(float)THRL),0)){ const float dl=__builtin_fmaxf(rm,0.f); mhat+=dl; \
        _Pragma("unroll") for(int r=0;r<16;++r){C0[r]-=dl;C1[r]-=dl;} \
        bq=hi?-mhat:1.0f; \
        const float f=__builtin_amdgcn_exp2f(-dl); l_reg*=f; if(hi==0)wsf[r32]=f; resc=true; } } \
    SBAR(); \
    GAPB(o[0]=__builtin_amdgcn_mfma_f32_32x32x16_bf16(PAF(0),VFR(0),o[0],0,0,0), C0,0); \
    GAPB(o[1]=__builtin_amdgcn_mfma_f32_32x32x16_bf16(PAF(0),VFR(4),o[1],0,0,0), C0,4); \
    KRD(GL,0); GAPB(o[0]=__builtin_amdgcn_mfma_f32_32x32x16_bf16(PAF(1),VFR(1),o[0],0,0,0), C0,8); \
    KRD(GL,1); GAPB(o[1]=__builtin_amdgcn_mfma_f32_32x32x16_bf16(PAF(1),VFR(5),o[1],0,0,0), C0,12); \
    KRD(GL,2); GAPB(o[0]=__builtin_amdgcn_mfma_f32_32x32x16_bf16(PAF(2),VFR(2),o[0],0,0,0), C1,0); \
    KRD(GL,3); GAPB(o[1]=__builtin_amdgcn_mfma_f32_32x32x16_bf16(PAF(2),VFR(6),o[1],0,0,0), C1,4); \
    GAPB(o[0]=__builtin_amdgcn_mfma_f32_32x32x16_bf16(PAF(3),VFR(3),o[0],0,0,0), C1,8); \
    GAPB(o[1]=__builtin_amdgcn_mfma_f32_32x32x16_bf16(PAF(3),VFR(7),o[1],0,0,0), C1,12); \
    }while(0)
  int t=1;
  #undef CMASK
  #define CMASK(P0,P1,t) do{}while(0)
  for(;t+5<NT;t+=2){
    STEP(pB0,pB1,pA0,pA1,t,true,true,true,true);     WAIT_BAR(3); RESC(); NEXTL(t+1); ROT();
    STEP(pA0,pA1,pB0,pB1,t+1,true,true,true,true);   WAIT_BAR(3); RESC(); NEXTL(t+2); ROT();
  }
  #undef CMASK
  #define CMASK(P0,P1,t) do{int jb_=(t)-(NT-4); if(jb_>=0)cmask(P0,P1,jb_,qrel,hi);}while(0)
  #define ENDW(tt) do{ if((tt)+3<NT){WAIT_BAR(3);} else if((tt)+2<NT){WAIT_BAR(2);} else {WAIT_BAR(0);} }while(0)
  for(;t+1<NT;t+=2){
    STEP(pB0,pB1,pA0,pA1,t,(t+3<NT),(t+1<NT),(t+1<NT),(t+2<NT));       ENDW(t);   RESC(); NEXTL(t+1); ROT();
    STEP(pA0,pA1,pB0,pB1,t+1,(t+4<NT),(t+2<NT),(t+2<NT),(t+3<NT));     ENDW(t+1); RESC(); NEXTL(t+2); ROT();
  }
  STEP(pB0,pB1,pA0,pA1,NT-1,false,false,false,false); RESC();
  { float sacc=pB0[0]+pB0[1]; _Pragma("unroll") for(int r=2;r<16;++r)sacc+=pB0[r]; _Pragma("unroll") for(int r=0;r<16;++r)sacc+=pB1[r]; l_reg+=sacc;
    pw0=(u32x4){PKW(pB0,0),PKW(pB0,2),PKW(pB0,4),PKW(pB0,6)};pw1=(u32x4){PKW(pB0,8),PKW(pB0,10),PKW(pB0,12),PKW(pB0,14)};pw2=(u32x4){PKW(pB1,0),PKW(pB1,2),PKW(pB1,4),PKW(pB1,6)};pw3=(u32x4){PKW(pB1,8),PKW(pB1,10),PKW(pB1,12),PKW(pB1,14)};
    SBAR(); pv(o,vb0+sl_cur,PAF(0),PAF(1),PAF(2),PAF(3)); }
  #undef PKW
  #undef PAF
  #undef VFR
  #undef PIN
  #undef MX3
  #undef GAPA
  #undef GAPB
  #undef EX
  #undef VRD
  #undef KRD
  #undef STEP
  #undef ENDW
  #undef NEXTB
  #undef NEXTL
  #undef FLOAD
  {auto rr=__builtin_amdgcn_permlane32_swap(__float_as_uint(l_reg),__float_as_uint(l_reg),false,false);l_reg=__uint_as_float(rr[0])+__uint_as_float(rr[1]);}
  if(hi==0)wsf[32+r32]=l_reg;asm volatile("s_waitcnt lgkmcnt(0)":::"memory");
  float rli[16];
  #pragma unroll
  for(int r=0;r<16;++r)rli[r]=__builtin_amdgcn_rcpf(wsf[32+crow(r,hi)]);
  bf16*Ow=O+(rowbase+q0+wid*QBLK)*OP+h*D;
  { bf16*stg=(bf16*)(shm+LDS_OST)+wid*2048;
    #pragma unroll
    for(int r=0;r<16;++r){const int orow=crow(r,hi);
      #pragma unroll
      for(int d0=0;d0<2;++d0)stg[orow*64+d0*32+r32]=__float2bfloat16(o[d0][r]*rli[r]);}
    asm volatile("s_waitcnt lgkmcnt(0)":::"memory");
    #pragma unroll
    for(int i=0;i<4;++i){const int row=i*8+(lane>>3),ch=lane&7; const u32x4 v=*(const u32x4*)(stg+row*64+ch*8); *(u32x4*)(Ow+(long)row*OP+ch*8)=v;} }
  asm volatile("s_waitcnt lgkmcnt(0)\n\ts_barrier":::"memory");
  #undef DMA_K
  #undef DMA_V
  #undef CMASK
  #undef START
  #undef RESC
  #undef ROT
}
constexpr int ATTN_LDS_BYTES=LDS_BYTES;
#undef SBAR
#undef WAIT_BAR
#undef AUGM
}

constexpr int NWAVES = 8;
constexpr int BATCH = 2, SEQ = 8192, T = BATCH * SEQ, D = 1024, DEPTH = 4;
constexpr int NZ = 2560, NINP = 2816;
constexpr int NE = 32, TOPK = 4, MROWS = 73728;
constexpr float LN_EPS = 1e-5f, RMS_EPS = 1e-6f, DN_ALPHA = 1.6817928305074290f;
constexpr int FOXH = 6, GLAH = 4, GDK = 48, GDV = 96, GCH = 64, NCHUNK = SEQ / GCH;

constexpr size_t MiB = 1u << 20;
constexpr size_t WS_CTL = 0, CTL_ZERO_BYTES = 1 * MiB;
constexpr size_t WS_MODP = 1 * MiB;
constexpr size_t WS_MOD = 3 * MiB;
constexpr size_t WS_BINP = 3 * MiB + 512 * 1024;
constexpr size_t WS_WRT = 4 * MiB;
constexpr size_t WS_FCUM = 5 * MiB;
constexpr size_t WS_LF = 5 * MiB + 512 * 1024;
constexpr size_t WS_TOKE = 6 * MiB;
constexpr size_t WS_TOKS = 6 * MiB + 512 * 1024;
constexpr size_t WS_TOKG = 7 * MiB;
constexpr size_t WS_LIST = 12 * MiB;
constexpr size_t WS_DEC = 8 * MiB;
constexpr size_t WS_ZF = 10 * MiB;
constexpr size_t WS_WIN = 16 * MiB;
constexpr size_t WS_WOUT = 40 * MiB;
constexpr size_t WS_WGU = 64 * MiB;
constexpr size_t WS_WDN = 576 * MiB;
constexpr size_t WS_X0 = 832 * MiB, WS_X1 = 896 * MiB, WS_Y = 960 * MiB;
constexpr size_t WS_H = 1024 * MiB, WS_H2 = 1056 * MiB, WS_MIX = 1088 * MiB;
constexpr size_t WS_Z = 1120 * MiB;
constexpr size_t WS_KV = 1200 * MiB, WS_ST = 1220 * MiB;
constexpr size_t WS_QIN = 1232 * MiB, WS_KIN = 1240 * MiB;
constexpr size_t WS_WPT = 1248 * MiB;
constexpr size_t WS_XROWS = 1280 * MiB, WS_ACT = 1424 * MiB, WS_YROWS = 1568 * MiB;
constexpr size_t WS_END = 1712 * MiB;
constexpr int CW_BAR = 4096;
constexpr int CW_CNT = 16384;
constexpr int CW_RDY = 65536;
constexpr int CW_CONVQ = 44032;
constexpr int CW_NRM = 43008;
constexpr int CW_TAILQ = 40960, CW_SCAN = 41984;

constexpr int RING_OFF = 0, RING_BYTES = 131072;
constexpr int LDSCTL_OFF = RING_BYTES, MISC_OFF = LDSCTL_OFF + 320;
constexpr int LX_TAB = MISC_OFF + 128;
constexpr int LX_PST = LX_TAB + 320 * 4;
constexpr int LX_CNT = LX_PST + 64 * 4;
constexpr int LX_HIST = LX_CNT + 64 * 4;
constexpr int LX_SCR = LX_HIST + 64 * 4;
constexpr int LDS_BYTES = 147456;
static_assert(LX_SCR + 2048 + 64 + 64 <= RING_OFF + pg8::TOKL_OFF && RING_OFF + pg8::TOKL_OFF + 8192 <= LDS_BYTES, "LDS map");

#define GAS __attribute__((address_space(1)))
#define LAS __attribute__((address_space(3)))
typedef unsigned short bf16;
typedef unsigned v4u __attribute__((ext_vector_type(4)));
typedef float f32x4 __attribute__((ext_vector_type(4)));
typedef short bf16x8 __attribute__((ext_vector_type(8)));
typedef GAS unsigned gu32;
typedef GAS unsigned long long gu64;
#define RLX_AGENT __ATOMIC_RELAXED, __HIP_MEMORY_SCOPE_AGENT
#define LDS_WAIT() asm volatile("s_waitcnt lgkmcnt(0)" ::: "memory")
#define VM_WAIT() asm volatile("s_waitcnt vmcnt(0)" ::: "memory")
__device__ __forceinline__ unsigned long long rt() { return __builtin_amdgcn_s_memrealtime(); }
__device__ __forceinline__ unsigned pk2(float lo, float hi) { return pg8::cvt_pk_bf16(lo, hi); }
__device__ __forceinline__ unsigned f2bf(float f) { return pg8::cvt_pk_bf16(f, 0.f) & 0xffffu; }

#define XB_TMO      128
#define XB_XCNT(j)  (256  + 64 * (j))
#define XB_XSUB(j)  (1280 + 64 * (j))
#define XB_XGEN(j)  (2304 + 64 * (j))
#define XB_TOP      3328
#define XB_TOPGEN   3392
#define XCD_BAR_WORDS 3456
#define XB_SPIN_CAP (1u << 18)

__device__ __forceinline__ unsigned xb_ld(unsigned* p)              { return __hip_atomic_load(p, __ATOMIC_RELAXED, __HIP_MEMORY_SCOPE_AGENT); }
__device__ __forceinline__ unsigned xb_add(unsigned* p, unsigned v) { return __hip_atomic_fetch_add(p, v, __ATOMIC_RELAXED, __HIP_MEMORY_SCOPE_AGENT); }
__device__ __forceinline__ unsigned xb_xcc_id() { return (unsigned)__builtin_amdgcn_s_getreg((3 << 11) | 20) & 0xFu; }
#define XB_SPIN(cond, bar) do { unsigned _sp = 0; while (cond) { __builtin_amdgcn_s_sleep(1); \
    if ((++_sp & 255u) == 0u) { if (xb_ld(&(bar)[XB_TMO])) break; if (_sp > XB_SPIN_CAP) { atomicAdd(&(bar)[XB_TMO], 1u); break; } } } } while (0)

struct XcdBarrier {
    unsigned* bar; unsigned x;
    volatile LAS unsigned* st;
};

__device__ __forceinline__ XcdBarrier xcd_barrier_post(unsigned* bar, volatile LAS unsigned* st) {
    XcdBarrier b; b.bar = bar; b.x = xb_xcc_id(); b.st = st;
    if (threadIdx.x == 0) (void)xb_add(&bar[XB_XCNT(b.x)], 1u);
    return b;
}
__device__ __forceinline__ void xcd_barrier_complete(unsigned* bar, unsigned x, unsigned& nloc, unsigned& nx) {
    const unsigned G = gridDim.x * gridDim.y * gridDim.z;
    unsigned sum, cnt, mine, sp = 0u;
    for (;;) {
        sum = 0u; cnt = 0u; mine = 0u;
#pragma unroll
        for (unsigned j = 0; j < 16; ++j) { const unsigned c = xb_ld(&bar[XB_XCNT(j)]); sum += c; cnt += (c > 0u) ? 1u : 0u; mine = (j == x) ? c : mine; }
        if (sum == G) break;
        __builtin_amdgcn_s_sleep(1);
        if ((++sp & 255u) == 0u) { if (xb_ld(&bar[XB_TMO])) break; if (sp > XB_SPIN_CAP) { atomicAdd(&bar[XB_TMO], 1u); break; } }
    }
    nloc = mine > 0u ? mine : 1u; nx = cnt > 0u ? cnt : 1u;
}

__device__ __forceinline__ void xcd_barrier(const XcdBarrier& b) {
    asm volatile("s_waitcnt vmcnt(0)" ::: "memory");
    __syncthreads();
    if (threadIdx.x == 0) {
        unsigned* bar = b.bar;
        __builtin_amdgcn_s_waitcnt(0);
        unsigned nloc = b.st[0], nx = b.st[1];
        if (nloc == 0u) { xcd_barrier_complete(bar, b.x, nloc, nx); b.st[0] = nloc; b.st[1] = nx; }
        const unsigned old = xb_add(&bar[XB_XSUB(b.x)], 1u);
        const unsigned gen = old / nloc;
        if (old + 1u == (gen + 1u) * nloc) {
            __builtin_amdgcn_fence(__ATOMIC_RELEASE, "agent");
            asm volatile("s_waitcnt vmcnt(0)" ::: "memory");
            const unsigned og = xb_add(&bar[XB_TOP], 1u);
            const unsigned tg = og / nx;
            if (og + 1u == (tg + 1u) * nx) xb_add(&bar[XB_TOPGEN], 1u);
            else XB_SPIN(xb_ld(&bar[XB_TOPGEN]) == tg, bar);
            __builtin_amdgcn_fence(__ATOMIC_ACQUIRE, "agent");
            xb_add(&bar[XB_XGEN(b.x)], 1u);
            asm volatile("s_waitcnt vmcnt(0)" ::: "memory");
        } else {
            XB_SPIN(xb_ld(&bar[XB_XGEN(b.x)]) == gen, bar);
            __builtin_amdgcn_fence(__ATOMIC_ACQUIRE, "agent");
            asm volatile("s_waitcnt vmcnt(0)" ::: "memory");
        }
    }
    __syncthreads();
}

struct Frame {
    LAS unsigned char* lds;
    volatile LAS unsigned* MISC;
    gu32* ctl;
    unsigned char* ws;
    int tid, lane, wave;
    int vcu, G;
};
__device__ __forceinline__ float wave_sum(float v) {
#define WS_DPP(x, ctrl) __builtin_bit_cast(float, __builtin_amdgcn_update_dpp(0, __builtin_bit_cast(int, (x)), (ctrl), 0xf, 0xf, false))
    v += WS_DPP(v, 0xB1); v += WS_DPP(v, 0x4E); v += WS_DPP(v, 0x141); v += WS_DPP(v, 0x140);
#undef WS_DPP
    const int iv = __builtin_bit_cast(int, v);
    return (__builtin_bit_cast(float, __builtin_amdgcn_readlane(iv, 0)) + __builtin_bit_cast(float, __builtin_amdgcn_readlane(iv, 16))) + (__builtin_bit_cast(float, __builtin_amdgcn_readlane(iv, 32)) + __builtin_bit_cast(float, __builtin_amdgcn_readlane(iv, 48)));
}
__device__ __forceinline__ float bf2f(unsigned v) { return __builtin_bit_cast(float, v << 16); }
__device__ __forceinline__ float log_sigmoidf(float x) { return fminf(x, 0.f) - __logf(1.0f + __expf(-fabsf(x))); }
__device__ __forceinline__ float siluf(float x) { return x * __builtin_amdgcn_rcpf(1.f + __expf(-x)); }
__device__ __forceinline__ f32x4 bf4_to_f32(unsigned long long w) { const unsigned lo = (unsigned)w, hi = (unsigned)(w >> 32); return (f32x4){bf2f(lo & 0xffffu), bf2f(lo >> 16), bf2f(hi & 0xffffu), bf2f(hi >> 16)}; }
__device__ __forceinline__ unsigned long long f32_to_bf4(f32x4 v) { return (unsigned long long)pk2(v.x, v.y) | ((unsigned long long)pk2(v.z, v.w) << 32); }
#define REFRESH_F() do { F.tid = opaque_tid(); F.lane = F.tid & 63; F.wave = __builtin_amdgcn_readfirstlane(F.tid >> 6); } while (0)
#define WG_SYNC() do { asm volatile("s_waitcnt vmcnt(0) lgkmcnt(0)" ::: "memory"); __syncthreads(); } while (0)

__device__ __forceinline__ void p0_tr_item(const float* W, int Nsrc, bf16* WT, int K, int n0, int k0, int kind, LAS float* scr, int lane) {
    const int n = n0 + (lane & 31);
    int col; float sc = 1.f;
    if (kind == 0) col = n;
    else if (kind == 1) { if (n < 1152) { col = n; if (n < 384) sc = attn_body::C2; } else if (n < 2304) col = n + 6; else if (n < 2560) col = n + 22; else if (n < 2566) col = n - 2560 + 1152; else if (n < 2582) col = n - 2566 + 2310; else col = -1; }
    else { const int pn = n >> 8, rr = n & 255; col = rr < 128 ? 128 * pn + rr : 1024 + 128 * pn + rr - 128; }
    float tv[32];
#pragma unroll
    for (int i = 0; i < 32; ++i) { const int kk = 2 * i + (lane >> 5); tv[i] = col >= 0 ? W[(size_t)(k0 + kk) * Nsrc + col] : 0.f; }
#pragma unroll
    for (int i = 0; i < 32; ++i) { const int kk = 2 * i + (lane >> 5); scr[kk * 33 + (lane & 31)] = tv[i] * sc; }
    LDS_WAIT(); asm volatile("" ::: "memory");
    const int c = lane & 7;
#pragma unroll
    for (int j = 0; j < 4; ++j) { const int nn = (lane >> 3) + 8 * j; const LAS float* s = scr + (8 * c) * 33 + nn;
        v4u o; o.x = pk2(s[0 * 33], s[1 * 33]); o.y = pk2(s[2 * 33], s[3 * 33]); o.z = pk2(s[4 * 33], s[5 * 33]); o.w = pk2(s[6 * 33], s[7 * 33]);
        *(GAS v4u*)(WT + (size_t)(n0 + nn) * K + k0 + 8 * c) = o; }
    LDS_WAIT(); asm volatile("" ::: "memory");
}
__device__ __forceinline__ void p0_tr_item_fp8(const float* W, int Nsrc, unsigned char* WT, int K, int n0, int k0, int kind, float scale, LAS float* scr, int lane) {
    const int n = n0 + (lane & 31);
    int col;
    if (kind == 0) col = n; else { const int pn = n >> 8, rr = n & 255; col = rr < 128 ? 128 * pn + rr : 1024 + 128 * pn + rr - 128; }
    float tv[32];
#pragma unroll
    for (int i = 0; i < 32; ++i) { const int kk = 2 * i + (lane >> 5); tv[i] = W[(size_t)(k0 + kk) * Nsrc + col]; }
#pragma unroll
    for (int i = 0; i < 32; ++i) { const int kk = 2 * i + (lane >> 5); scr[kk * 33 + (lane & 31)] = tv[i] * scale; }
    LDS_WAIT(); asm volatile("" ::: "memory");
    const int c = lane & 3;
#pragma unroll
    for (int j = 0; j < 2; ++j) { const int nn = (lane >> 2) + 16 * j; const LAS float* s = scr + (16 * c) * 33 + nn;
        v4u o; o.x = pg8::pk4_fp8(s[0 * 33], s[1 * 33], s[2 * 33], s[3 * 33]); o.y = pg8::pk4_fp8(s[4 * 33], s[5 * 33], s[6 * 33], s[7 * 33]);
        o.z = pg8::pk4_fp8(s[8 * 33], s[9 * 33], s[10 * 33], s[11 * 33]); o.w = pg8::pk4_fp8(s[12 * 33], s[13 * 33], s[14 * 33], s[15 * 33]);
        *(GAS v4u*)(WT + (size_t)(n0 + nn) * K + k0 + 16 * c) = o; }
    LDS_WAIT(); asm volatile("" ::: "memory");
}
struct P0It { const float* src; int stride; float sc; unsigned char* dst; int n0, k0, fp8; };
__device__ __forceinline__ P0It p0_decode(Frame& F, const float* const* in, int r, int lane) {
    constexpr int I_IN = DEPTH * 88 * 16, I_OUT = DEPTH * 32 * 16, I_GU = DEPTH * NE * 64 * 16;
    P0It t; int kind, nb, Nsrc; const float* W;
    if (r < I_IN) { const int l = r / (88 * 16), q = r % (88 * 16); nb = 88; kind = 1; Nsrc = 2582; W = in[4] + (size_t)l * D * 2582; t.dst = F.ws + WS_WIN + (size_t)l * NINP * D * 2; t.fp8 = 0; t.sc = 1.f; t.n0 = ((q >> 1) % nb) * 32; t.k0 = (((q >> 1) / nb) * 2 + (q & 1)) * 64; }
    else if ((r -= I_IN) < I_OUT) { const int l = r / (32 * 16), q = r % (32 * 16); nb = 32; kind = 0; Nsrc = D; W = in[11] + (size_t)l * D * D; t.dst = F.ws + WS_WOUT + (size_t)l * D * D * 2; t.fp8 = 0; t.sc = 1.f; t.n0 = ((q >> 1) % nb) * 32; t.k0 = (((q >> 1) / nb) * 2 + (q & 1)) * 64; }
    else if ((r -= I_OUT) < I_GU) { const int le = r / (64 * 16), q = r % (64 * 16); nb = 64; kind = 2; Nsrc = 2048; W = in[16] + (size_t)le * D * 2048; t.dst = F.ws + WS_WGU + (size_t)le * 2048 * D; t.fp8 = 1; t.sc = 32.f; t.n0 = ((q >> 1) % nb) * 32; t.k0 = (((q >> 1) / nb) * 2 + (q & 1)) * 64; }
    else { r -= I_GU; const int le = r / (32 * 16), q = r % (32 * 16); nb = 32; kind = 0; Nsrc = D; W = in[18] + (size_t)le * D * D; t.dst = F.ws + WS_WDN + (size_t)le * D * D; t.fp8 = 1; t.sc = 64.f; t.n0 = ((q >> 1) % nb) * 32; t.k0 = (((q >> 1) / nb) * 2 + (q & 1)) * 64; }
    const int n = t.n0 + (lane & 31); int col;
    if (kind == 0) col = n;
    else if (kind == 1) { if (n < 1152) { col = n; if (n < 384) t.sc = attn_body::C2; } else if (n < 2304) col = n + 6; else if (n < 2560) col = n + 22; else if (n < 2566) col = n - 2560 + 1152; else if (n < 2582) col = n - 2566 + 2310; else col = -1; }
    else { const int pn = n >> 8, rr = n & 255; col = rr < 128 ? 128 * pn + rr : 1024 + 128 * pn + rr - 128; }
    t.stride = Nsrc; t.src = col >= 0 ? W + (size_t)(t.k0 + (lane >> 5)) * Nsrc + col : nullptr;
    return t;
}
#define P0_ISSUE(T, TV) do { _Pragma("unroll") for (int i = 0; i < 32; ++i) TV[i] = (T).src ? __builtin_nontemporal_load((T).src + (size_t)(2 * i) * (T).stride) : 0.f; } while (0)
__device__ __forceinline__ void p0_finish(const P0It& t, const float (&tv)[32], LAS float* scr, int lane) {
#pragma unroll
    for (int i = 0; i < 32; ++i) { const int kk = 2 * i + (lane >> 5); scr[kk * 33 + (lane & 31)] = tv[i] * t.sc; }
    LDS_WAIT(); asm volatile("" ::: "memory");
    if (t.fp8) { const int c = lane & 3;
#pragma unroll
        for (int j = 0; j < 2; ++j) { const int nn = (lane >> 2) + 16 * j; const LAS float* s = scr + (16 * c) * 33 + nn;
            v4u o; o.x = pg8::pk4_fp8(s[0 * 33], s[1 * 33], s[2 * 33], s[3 * 33]); o.y = pg8::pk4_fp8(s[4 * 33], s[5 * 33], s[6 * 33], s[7 * 33]);
            o.z = pg8::pk4_fp8(s[8 * 33], s[9 * 33], s[10 * 33], s[11 * 33]); o.w = pg8::pk4_fp8(s[12 * 33], s[13 * 33], s[14 * 33], s[15 * 33]);
            *(GAS v4u*)(t.dst + (size_t)(t.n0 + nn) * D + t.k0 + 16 * c) = o; } }
    else { const int c = lane & 7;
#pragma unroll
        for (int j = 0; j < 4; ++j) { const int nn = (lane >> 3) + 8 * j; const LAS float* s = scr + (8 * c) * 33 + nn;
            v4u o; o.x = pk2(s[0 * 33], s[1 * 33]); o.y = pk2(s[2 * 33], s[3 * 33]); o.z = pk2(s[4 * 33], s[5 * 33]); o.w = pk2(s[6 * 33], s[7 * 33]);
            *(GAS v4u*)((bf16*)t.dst + (size_t)(t.n0 + nn) * D + t.k0 + 8 * c) = o; } }
    LDS_WAIT(); asm volatile("" ::: "memory");
}
constexpr int CONV_ITEMS_PER_LAYER = NE * 64 * 16 + NE * 32 * 16, CONV_GRANULES = CONV_ITEMS_PER_LAYER / 32;
struct P0It4 { const float* src; int stride; float sc; unsigned char* dst; int n0, k0; };
__device__ __forceinline__ P0It4 p0_decode4(Frame& F, const float* const* in, int L, int li, int lane) {
    constexpr int GU_L = NE * 64 * 16;
    P0It4 t; int col, Nsrc; const float* W; const int n4 = 4 * (lane & 7);
    if (li < GU_L) { const int e = li / (64 * 16), q = li % (64 * 16), le = L * NE + e; Nsrc = 2048; W = in[16] + (size_t)le * D * 2048; t.dst = F.ws + WS_WGU + (size_t)le * 2048 * D; t.sc = 32.f;
        t.n0 = ((q >> 1) % 64) * 32; t.k0 = (((q >> 1) / 64) * 2 + (q & 1)) * 64; const int n = t.n0 + n4, pn = n >> 8, rr = n & 255; col = rr < 128 ? 128 * pn + rr : 1024 + 128 * pn + rr - 128; }
    else { li -= GU_L; const int e = li / (32 * 16), q = li % (32 * 16), le = L * NE + e; Nsrc = D; W = in[18] + (size_t)le * D * D; t.dst = F.ws + WS_WDN + (size_t)le * D * D; t.sc = 64.f;
        t.n0 = ((q >> 1) % 32) * 32; t.k0 = (((q >> 1) / 32) * 2 + (q & 1)) * 64; col = t.n0 + n4; }
    t.stride = Nsrc; t.src = W + (size_t)(t.k0 + (lane >> 3)) * Nsrc + col;
    return t;
}
#define P0_ISSUE4(T, TQ) do { _Pragma("unroll") for (int i = 0; i < 8; ++i) TQ[i] = __builtin_nontemporal_load((const f32x4*)((T).src + (size_t)(8 * i) * (T).stride)); } while (0)
__device__ __forceinline__ void p0_finish4x2(const P0It4& tA, const f32x4 (&qA)[8], const P0It4& tB, const f32x4 (&qB)[8], LAS float* scrf, int lane) {
    LAS unsigned* scr = (LAS unsigned*)scrf;
#pragma unroll
    for (int i = 0; i < 8; ++i) { const int off = (lane & 7) * 68 + 8 * i + (lane >> 3);
        scr[off] = pg8::pk4_fp8(qA[i].x * tA.sc, qA[i].y * tA.sc, qA[i].z * tA.sc, qA[i].w * tA.sc);
        scr[576 + off] = pg8::pk4_fp8(qB[i].x * tB.sc, qB[i].y * tB.sc, qB[i].z * tB.sc, qB[i].w * tB.sc); }
    LDS_WAIT(); asm volatile("" ::: "memory");
    { const int l32 = lane & 31, kq = l32 & 3, g = l32 >> 2; const bool isB = lane >= 32;
      const LAS unsigned* src = scr + (isB ? 576 : 0) + g * 68 + 16 * kq;
      unsigned o[4][4];
#pragma unroll
      for (int blk = 0; blk < 4; ++blk) { const v4u r4 = *(const LAS v4u*)(src + 4 * blk);
          const unsigned t0 = __builtin_amdgcn_perm(r4.y, r4.x, 0x05010400u), t1 = __builtin_amdgcn_perm(r4.y, r4.x, 0x07030602u), t2 = __builtin_amdgcn_perm(r4.w, r4.z, 0x05010400u), t3 = __builtin_amdgcn_perm(r4.w, r4.z, 0x07030602u);
          o[0][blk] = __builtin_amdgcn_perm(t2, t0, 0x05040100u); o[1][blk] = __builtin_amdgcn_perm(t2, t0, 0x07060302u); o[2][blk] = __builtin_amdgcn_perm(t3, t1, 0x05040100u); o[3][blk] = __builtin_amdgcn_perm(t3, t1, 0x07060302u); }
      unsigned char* dst = isB ? tB.dst : tA.dst; const int n0 = isB ? tB.n0 : tA.n0, k0 = isB ? tB.k0 : tA.k0;
#pragma unroll
      for (int j = 0; j < 4; ++j) { v4u w; w.x = o[j][0]; w.y = o[j][1]; w.z = o[j][2]; w.w = o[j][3]; __builtin_nontemporal_store(w, (v4u*)(dst + (size_t)(n0 + 4 * g + j) * D + k0 + 16 * kq)); } }
    LDS_WAIT(); asm volatile("" ::: "memory");
}
__device__ __forceinline__ void conv_run(Frame& F, const float* const* in, int L, gu32* qv, LAS int* slot) {
    LAS float* scr = (LAS float*)(F.lds + RING_OFF + F.wave * 16384); const int lane = F.lane;
    unsigned nreq = 0u;
    if (F.tid == 0) { *slot = (int)__hip_atomic_fetch_add(qv, 1u, RLX_AGENT); nreq = __hip_atomic_fetch_add(qv, 1u, RLX_AGENT); }
    WG_SYNC();
    int gi = __builtin_amdgcn_readfirstlane(*slot);
    WG_SYNC();
    if (gi >= CONV_GRANULES) return;
    f32x4 tqA[8], tqB[8], tqC[8], tqD[8]; P0It4 tA, tB, tC, tD;
    { const int li0 = 32 * gi + 4 * F.wave;
      tA = p0_decode4(F, in, L, li0, lane); tB = p0_decode4(F, in, L, li0 + 1, lane); tC = p0_decode4(F, in, L, li0 + 2, lane); tD = p0_decode4(F, in, L, li0 + 3, lane);
      P0_ISSUE4(tA, tqA); P0_ISSUE4(tB, tqB); P0_ISSUE4(tC, tqC); P0_ISSUE4(tD, tqD); }
    for (;;) {
        if (F.tid == 0) *slot = (int)nreq;
        WG_SYNC();
        const int gn = __builtin_amdgcn_readfirstlane(*slot); const bool more = gn < CONV_GRANULES;
        if (F.tid == 0 && more) nreq = __hip_atomic_fetch_add(qv, 1u, RLX_AGENT);
        const int ln0 = 32 * gn + 4 * F.wave;
        const P0It4 uA = tA, uB = tB;
        p0_finish4x2(uA, tqA, uB, tqB, scr, lane);
        if (more) { tA = p0_decode4(F, in, L, ln0, lane); tB = p0_decode4(F, in, L, ln0 + 1, lane); P0_ISSUE4(tA, tqA); P0_ISSUE4(tB, tqB); }
        const P0It4 uC = tC, uD = tD;
        p0_finish4x2(uC, tqC, uD, tqD, scr, lane);
        if (more) { tC = p0_decode4(F, in, L, ln0 + 2, lane); tD = p0_decode4(F, in, L, ln0 + 3, lane); P0_ISSUE4(tC, tqC); P0_ISSUE4(tD, tqD); }
        WG_SYNC();
        if (!more) break;
    }
}
__device__ __forceinline__ void ph_convert(Frame& F, const float* const* in) {
    LAS float* scr = (LAS float*)(F.lds + RING_OFF + F.wave * 16384);
    const int gw = F.vcu * NWAVES + F.wave, NGW = F.G * NWAVES, lane = F.lane;
    constexpr int I_IN = DEPTH * 88 * 16, I_OUT = DEPTH * 32 * 16, I_GU = DEPTH * NE * 64 * 16, I_DN = DEPTH * NE * 32 * 16, I_MOD = DEPTH * 8 * 96, I_WR = DEPTH * 16;
    for (int r = gw; r < I_MOD + I_WR; r += NGW) {
        if (r < I_MOD) {
            const int l = r / 768, q = r % 768, kp = q / 96, j = (q % 96) * 64 + lane;
            const float* c = in[1]; const float* wa = in[2] + ((size_t)l * D + kp * 128) * 6144 + j;
            float a0 = 0.f, a1 = 0.f;
#pragma unroll 16
            for (int k = 0; k < 128; ++k) { const float w = wa[(size_t)k * 6144]; a0 += siluf(c[kp * 128 + k]) * w; a1 += siluf(c[D + kp * 128 + k]) * w; }
            float* mp = (float*)(F.ws + WS_MODP) + ((size_t)(l * 8 + kp) * 2) * 6144 + j; mp[0] = a0; mp[6144] = a1; }
        else { const int rw = r - I_MOD;
            const int l = rw / 16, k0 = (rw % 16) * 64; const float* wr = in[14] + (size_t)l * D * NE; float* wt = (float*)(F.ws + WS_WRT) + (size_t)l * NE * D;
            for (int i = 0; i < 32; ++i) { const int idx = i * 64 + lane, kk = idx >> 5, e = idx & 31; scr[e * 65 + kk] = wr[(size_t)(k0 + kk) * NE + e]; }
            LDS_WAIT(); asm volatile("" ::: "memory");
            for (int e = 0; e < 32; ++e) wt[(size_t)e * D + k0 + lane] = scr[e * 65 + lane];
            LDS_WAIT(); asm volatile("" ::: "memory"); }
    }
    { constexpr int NIT = I_IN + I_OUT;
      (void)I_DN; (void)I_GU;
#define P0R(i) ((i) < I_IN + I_OUT + I_GU / DEPTH ? (i) : (i) + (I_GU - I_GU / DEPTH))
      float tvA[32], tvB[32]; P0It tA, tB; int it = 2 * gw;
      if (it < NIT) { tA = p0_decode(F, in, P0R(it), lane); P0_ISSUE(tA, tvA); }
      for (; it < NIT; it += 2 * NGW) {
          tB = p0_decode(F, in, P0R(it + 1), lane); P0_ISSUE(tB, tvB);
          p0_finish(tA, tvA, scr, lane);
          if (it + 2 * NGW < NIT) { tA = p0_decode(F, in, P0R(it + 2 * NGW), lane); P0_ISSUE(tA, tvA); }
          p0_finish(tB, tvB, scr, lane); }
#undef P0R
    }
    for (int i = (F.vcu * NWAVES + F.wave) * 64 + lane; i < DEPTH * 4 * 64 * 64; i += NGW * 64) { const int lg = i >> 12, d = (i >> 6) & 63, c = i & 63; ((bf16*)(F.ws + WS_WPT))[i] = (bf16)f2bf(in[9][(size_t)(lg * 64 + c) * 64 + d]); }
    for (int i = (F.vcu * NWAVES + F.wave) * 64 + lane; i < DEPTH * NINP; i += NGW * 64) {
        const int l = i / NINP, n = i % NINP; int col; float sc = 1.f;
        if (n < 1152) { col = n; if (n < 384) sc = attn_body::C2; } else if (n < 2304) col = n + 6; else if (n < 2560) col = n + 22; else if (n < 2566) col = n - 2560 + 1152; else if (n < 2582) col = n - 2566 + 2310; else col = -1;
        ((float*)(F.ws + WS_BINP))[i] = col >= 0 ? in[5][(size_t)l * 2582 + col] * sc : 0.f;
    }
}
__device__ __forceinline__ void ph_modfin(Frame& F, const float* const* in) {
    const float* mp = (const float*)(F.ws + WS_MODP); float* mod = (float*)(F.ws + WS_MOD);
    for (int i = F.vcu * 512 + F.tid; i < DEPTH * 2 * 6144; i += F.G * 512) {
        const int l = i / 12288, q = i % 12288, b = q / 6144, j = q % 6144;
        float s = in[3][(size_t)l * 6144 + j];
#pragma unroll
        for (int p = 0; p < 8; ++p) s += mp[((size_t)(l * 8 + p) * 2 + b) * 6144 + j];
        mod[i] = s;
    }
}
__device__ __forceinline__ void ph_mod0(Frame& F, const float* x) {
    const int gw = F.vcu * NWAVES + F.wave, NGW = F.G * NWAVES, lane = F.lane;
    const float* mod = (const float*)(F.ws + WS_MOD); bf16* H = (bf16*)(F.ws + WS_H);
    for (int m = gw; m < T; m += NGW) {
        const int b = m >> 13; const float* mb = mod + (size_t)b * 6144;
        const GAS f32x4* xr = (const GAS f32x4*)(x + (size_t)m * D) + lane;
        GAS unsigned long long* o8 = (GAS unsigned long long*)(H + (size_t)m * D) + lane;
        GAS unsigned long long* x8 = (GAS unsigned long long*)((bf16*)(F.ws + WS_X0) + (size_t)m * D) + lane;
#pragma unroll
        for (int j = 0; j < 4; ++j) { const f32x4 v = xr[64 * j]; const int c0 = 256 * j + 4 * lane;
            const f32x4 sh = *(const f32x4*)(mb + c0), sc = *(const f32x4*)(mb + 1024 + c0);
            const f32x4 h = v * (sc + 1.0f) + sh;
            x8[64 * j] = f32_to_bf4(v);
            o8[64 * j] = (unsigned long long)pk2(h.x, h.y) | ((unsigned long long)pk2(h.z, h.w) << 32); }
    }
}

typedef float f32x16 __attribute__((ext_vector_type(16)));
typedef unsigned short u16x4 __attribute__((ext_vector_type(4)));
__device__ __forceinline__ f32x16 mfma32(bf16x8 a, bf16x8 b, f32x16 c) { return __builtin_amdgcn_mfma_f32_32x32x16_bf16(a, b, c, 0, 0, 0); }
__device__ __forceinline__ int crow(int r, int hi) { return (r & 3) + 8 * (r >> 2) + 4 * hi; }
__device__ __forceinline__ void ph_fcum(Frame& F) {
    const float* LFp = (const float*)(F.ws + WS_LF); float* FC = (float*)(F.ws + WS_FCUM);
    LAS float* wtot = (LAS float*)(F.lds + LX_SCR);
    for (int u = blockIdx.x; u < BATCH * FOXH; u += F.G) {
        const int b = u / FOXH, h = u % FOXH, t0 = F.tid * 16;
        float v[16]; float run = 0.f;
#pragma unroll
        for (int k4 = 0; k4 < 4; ++k4) { const f32x4 q = *(const f32x4*)(LFp + (size_t)u * SEQ + t0 + 4 * k4);
#pragma unroll
            for (int j = 0; j < 4; ++j) { run += q[j]; v[4 * k4 + j] = run; } }
        float inc = run;
#pragma unroll
        for (int off = 1; off < 64; off <<= 1) { const float y = __shfl_up(inc, off); if (F.lane >= off) inc += y; }
        if (F.lane == 63) wtot[F.wave] = inc;
        WG_SYNC();
        float base = 0.f;
        for (int w = 0; w < F.wave; ++w) base += wtot[w];
        const float excl = base + inc - run;
#pragma unroll
        for (int k = 0; k < 16; ++k) FC[(size_t)u * SEQ + t0 + k] = excl + v[k];
        WG_SYNC();
    }
}
__device__ __forceinline__ void ph_qknorm(Frame& F, gu32* nrm) {
    const bf16* Z = (const bf16*)(F.ws + WS_Z); const int lane = F.lane;
    LAS float* red = (LAS float*)(F.lds + LX_SCR + 2048 + 64);
    const int g = (int)blockIdx.x % 24, rank = (int)blockIdx.x / 24, ng = (F.G - g + 23) / 24;
    const int bh = g % (BATCH * FOXH), kind = g / (BATCH * FOXH), b = bh / FOXH, h = bh % FOXH;
    const bf16* base = Z + (size_t)(b * SEQ + (lane >> 3)) * NZ + kind * 384 + h * 64 + (lane & 7) * 8;
    float m = 0.f;
#pragma unroll 4
    for (int rg = rank * NWAVES + F.wave; rg < SEQ / 8; rg += ng * NWAVES) {
        const v4u v = *(const GAS v4u*)(base + (size_t)rg * 8 * NZ);
        const unsigned w[4] = {v.x, v.y, v.z, v.w}; float ss = 0.f;
#pragma unroll
        for (int j = 0; j < 4; ++j) { const float a = bf2f(w[j] & 0xffffu), c = bf2f(w[j] >> 16); ss += a * a + c * c; }
        ss += __shfl_xor(ss, 1); ss += __shfl_xor(ss, 2); ss += __shfl_xor(ss, 4);
        m = fmaxf(m, ss);
    }
    m = fmaxf(m, __shfl_xor(m, 8)); m = fmaxf(m, __shfl_xor(m, 16)); m = fmaxf(m, __shfl_xor(m, 32));
    if (lane == 0) red[F.wave] = m;
    WG_SYNC();
    if (F.tid == 0) { float mm = red[0];
#pragma unroll
        for (int w = 1; w < NWAVES; ++w) mm = fmaxf(mm, red[w]);
        __hip_atomic_fetch_max(nrm + g, __float_as_uint(mm), RLX_AGENT); }
    WG_SYNC();
}
__device__ __forceinline__ void ph_gla1(Frame& F, const float* wa2, const float* ba) {
    const bf16* Z = (const bf16*)(F.ws + WS_Z); const float* ZF = (const float*)(F.ws + WS_ZF);
    float* KVT = (float*)(F.ws + WS_KV); float* DEC = (float*)(F.ws + WS_DEC); bf16* QIN = (bf16*)(F.ws + WS_QIN); bf16* KIN = (bf16*)(F.ws + WS_KIN);
    const int hf = F.tid >> 8, tl = F.tid & 255, wl = F.wave & 3;
    LAS unsigned char* base = F.lds + RING_OFF + hf * 40960;
    LAS float* ga = (LAS float*)base, *bcum = ga + 1024;
    LAS bf16* KOT = (LAS bf16*)(base + 16640); LAS bf16* VT = (LAS bf16*)(base + 25856);
    LAS float* WA = (LAS float*)(F.lds + RING_OFF + 81920); LAS float* BA = WA + 16 * 192;
    for (int idx = F.tid; idx < 16 * 192; idx += 512) WA[idx] = wa2[idx];
    if (F.tid < 192) BA[F.tid] = ba[F.tid];
    const int lane = F.lane, r32 = lane & 31, hi = lane >> 5;
    for (int p = blockIdx.x; p < BATCH * GLAH * NCHUNK / 2; p += F.G) {
        const int u = 2 * p + hf;
        const int bh = u / NCHUNK, n = u % NCHUNK, b = bh / GLAH, h = bh % GLAH, row0 = b * SEQ + n * GCH;
        v4u q8[2], k8[2];
#pragma unroll
        for (int k = 0; k < 2; ++k) { const int idx = tl + 256 * k; q8[k] = (v4u){0u, 0u, 0u, 0u}; k8[k] = q8[k];
            if (idx < 384) { const int qi = idx & 63, qc = idx >> 6; q8[k] = *(const GAS v4u*)(Z + (size_t)(row0 + qi) * NZ + 1152 + h * GDK + qc * 8); k8[k] = *(const GAS v4u*)(Z + (size_t)(row0 + qi) * NZ + 1344 + h * GDK + qc * 8); } }
#pragma unroll
        for (int k = 0; k < 3; ++k) { const int idx = tl + 256 * k, j = idx & 63, c12 = idx >> 6; const v4u v8 = *(const GAS v4u*)(Z + (size_t)(row0 + j) * NZ + 1536 + h * GDV + c12 * 8);
            const unsigned w[4] = {v8.x, v8.y, v8.z, v8.w};
#pragma unroll
            for (int e = 0; e < 8; ++e) VT[(c12 * 8 + e) * 72 + j] = (bf16)((w[e >> 1] >> ((e & 1) * 16)) & 0xffffu); }
#pragma unroll
        for (int k = 0; k < 4; ++k) { const int idx = tl + 256 * k, i = idx >> 4, r = idx & 15; ga[idx] = ZF[(size_t)(row0 + i) * 32 + 6 + r]; }
        WG_SYNC();
        for (int idx = tl; idx < GCH * GDK; idx += 256) { const int i = idx / GDK, d = idx % GDK; float sacc = BA[h * GDK + d];
#pragma unroll
            for (int r = 0; r < 16; ++r) sacc += ga[i * 16 + r] * WA[r * 192 + h * GDK + d];
            bcum[i * 49 + d] = log_sigmoidf(sacc) * (1.0f / 16.0f); }
        WG_SYNC();
        if (tl < GDK) { float vals[GCH];
#pragma unroll
            for (int i = 0; i < GCH; ++i) vals[i] = bcum[i * 49 + tl];
            float run = 0.f;
#pragma unroll
            for (int i = 0; i < GCH; ++i) { run += vals[i]; bcum[i * 49 + tl] = run; } }
        WG_SYNC();
#pragma unroll
        for (int k = 0; k < 2; ++k) { const int idx = tl + 256 * k;
            if (idx < 384) { const int qi = idx & 63, qc = idx >> 6; const unsigned qw[4] = {q8[k].x, q8[k].y, q8[k].z, q8[k].w}, kw[4] = {k8[k].x, k8[k].y, k8[k].z, k8[k].w}; float qo[8], ko[8];
#pragma unroll
                for (int e = 0; e < 8; ++e) { const int d = qc * 8 + e; const float bb = bcum[qi * 49 + d], eb = __expf(bb), ei = __expf(-bb);
                    qo[e] = bf2f((qw[e >> 1] >> ((e & 1) * 16)) & 0xffffu) * 0.14433756729740643f * eb; ko[e] = bf2f((kw[e >> 1] >> ((e & 1) * 16)) & 0xffffu) * ei;
                    KOT[d * 72 + qi] = (bf16)f2bf(ko[e] * __expf(bcum[63 * 49 + d])); }
                v4u o; o.x = pk2(qo[0], qo[1]); o.y = pk2(qo[2], qo[3]); o.z = pk2(qo[4], qo[5]); o.w = pk2(qo[6], qo[7]); *(GAS v4u*)(QIN + (size_t)u * 3072 + qi * GDK + qc * 8) = o;
                o.x = pk2(ko[0], ko[1]); o.y = pk2(ko[2], ko[3]); o.z = pk2(ko[4], ko[5]); o.w = pk2(ko[6], ko[7]); *(GAS v4u*)(KIN + (size_t)u * 3072 + qi * GDK + qc * 8) = o; } }
        if (tl < GDK) DEC[(size_t)u * GDK + tl] = __expf(bcum[63 * 49 + tl]);
        WG_SYNC();
#pragma unroll
        for (int tt = 0; tt < 2; ++tt) { const int tile = wl + 4 * tt;
            if (tile < 6) { const int dt = tile / 3, vt = tile % 3; f32x16 acc = {};
#pragma unroll
                for (int sx = 0; sx < 4; ++sx) { const bf16x8 a = *(const LAS bf16x8*)(KOT + (32 * dt + r32) * 72 + 16 * sx + 8 * hi), bb = *(const LAS bf16x8*)(VT + (32 * vt + r32) * 72 + 16 * sx + 8 * hi); acc = mfma32(a, bb, acc); }
                float* kv = KVT + (size_t)u * (GDK * GDV) + (size_t)(32 * vt + r32) * GDK;
#pragma unroll
                for (int q4 = 0; q4 < 4; ++q4) { const int d0 = 32 * dt + 8 * q4 + 4 * hi; if (d0 < GDK) *(f32x4*)(kv + d0) = (f32x4){acc[4 * q4], acc[4 * q4 + 1], acc[4 * q4 + 2], acc[4 * q4 + 3]}; } } }
        WG_SYNC();
    }
}
__device__ __forceinline__ void pool_unit(Frame& F, int u, const bf16* wpt, const float* ps) {
    const bf16* Z = (const bf16*)(F.ws + WS_Z); bf16* MIX = (bf16*)(F.ws + WS_MIX);
    LAS bf16* UB = (LAS bf16*)(F.lds + RING_OFF); LAS bf16* PB = (LAS bf16*)(F.lds + RING_OFF + 40448); LAS bf16* WP = (LAS bf16*)(F.lds + RING_OFF + 74240);
    const int lane = F.lane, r32 = lane & 31, hi = lane >> 5;
    {
        const int t0 = u * 64, bbase = (t0 >> 13) << 13;
        for (int idx = F.tid; idx < 79 * 32; idx += 512) { const int r = idx >> 5, c32 = idx & 31, tt = t0 - 15 + r;
            v4u val = (v4u){0u, 0u, 0u, 0u}; if (tt >= bbase) val = *(const GAS v4u*)(Z + (size_t)tt * NZ + 2304 + c32 * 8);
            *(LAS v4u*)(UB + r * 256 + c32 * 8) = val; }
        for (int idx = F.tid; idx < 2048; idx += 512) { const int gd = idx >> 3, c8 = idx & 7; *(LAS v4u*)(WP + gd * 72 + c8 * 8) = *(const GAS v4u*)(wpt + gd * 64 + c8 * 8); }
        WG_SYNC();
        { const int c = F.tid & 255, half = F.tid >> 8, g = c >> 6, w = 2 << g, i0 = half * 32; int pos = t0 - bbase + i0;
          float s = 0.f; for (int j = 1; j < w; ++j) s += bf2f(UB[(15 + i0 - j) * 256 + c]);
          for (int i = i0; i < i0 + 32; ++i, ++pos) { const float ui = bf2f(UB[(15 + i) * 256 + c]); s += ui; const int cnt = pos + 1 < w ? pos + 1 : w;
              PB[i * 264 + c] = (bf16)f2bf(s / (float)cnt - ui); s -= bf2f(UB[(15 + i - (w - 1)) * 256 + c]); } }
        WG_SYNC();
        { const int g = F.wave & 3, it = F.wave >> 2;
#pragma unroll
          for (int dt = 0; dt < 2; ++dt) { f32x16 acc = {};
#pragma unroll
              for (int s = 0; s < 4; ++s) { const bf16x8 a = *(const LAS bf16x8*)(PB + (32 * it + r32) * 264 + g * 64 + 16 * s + 8 * hi), bb = *(const LAS bf16x8*)(WP + (g * 64 + 32 * dt + r32) * 72 + 16 * s + 8 * hi); acc = mfma32(a, bb, acc); }
              const int col = g * 64 + 32 * dt + r32; const float sc = ps[col];
#pragma unroll
              for (int r = 0; r < 16; ++r) MIX[(size_t)(t0 + 32 * it + crow(r, hi)) * D + 768 + col] = (bf16)f2bf(acc[r] * sc); } }
        WG_SYNC();
    }
}
__device__ __forceinline__ void ph_glascan(Frame& F, gu32* done) {
    const float* KVT = (const float*)(F.ws + WS_KV); const float* DEC = (const float*)(F.ws + WS_DEC); bf16* ST = (bf16*)(F.ws + WS_ST);
    constexpr int NEL = BATCH * GLAH * GDK * GDV;
    for (int blk = F.G - 1 - (int)blockIdx.x; blk * 512 < NEL; blk += F.G) {
        const int gid = blk * 512 + F.tid;
        if (gid < NEL) {
            const int bh = gid / (GDK * GDV), e = gid % (GDK * GDV), d = e % GDK; float S = 0.f;
#pragma unroll 8
            for (int n = 0; n < NCHUNK; ++n) { const size_t ix = (size_t)bh * NCHUNK + n;
                __hip_atomic_store(ST + ix * (GDK * GDV) + e, (bf16)f2bf(S), __ATOMIC_RELAXED, __HIP_MEMORY_SCOPE_AGENT);
                S = S * DEC[ix * GDK + d] + KVT[ix * (GDK * GDV) + e]; } }
        WG_SYNC();
        if (F.tid == 0) __hip_atomic_fetch_add(done, 1u, RLX_AGENT);
    }
}
constexpr int NPOOLU = T / 64, NGLA3U = BATCH * GLAH * NCHUNK, NSCANBLK = (BATCH * GLAH * GDK * GDV + 511) / 512;
__device__ __forceinline__ void gla3_unit(Frame& F, int u, const float* gng) {
    const bf16* Z = (const bf16*)(F.ws + WS_Z); const bf16* ST = (const bf16*)(F.ws + WS_ST); const bf16* QIN = (const bf16*)(F.ws + WS_QIN); const bf16* KIN = (const bf16*)(F.ws + WS_KIN); bf16* MIX = (bf16*)(F.ws + WS_MIX);
    LAS bf16* QI = (LAS bf16*)(F.lds + RING_OFF); LAS bf16* KI = (LAS bf16*)(F.lds + RING_OFF + 7168); LAS bf16* VT = (LAS bf16*)(F.lds + RING_OFF + 14336); LAS bf16* STT = (LAS bf16*)(F.lds + RING_OFF + 28160);
    LAS float* OB = (LAS float*)(F.lds + RING_OFF + 38912);
    const int lane = F.lane, r32 = lane & 31, hi = lane >> 5;
    {
        const int bh = u / NCHUNK, n = u % NCHUNK, b = bh / GLAH, h = bh % GLAH, row0 = b * SEQ + n * GCH;
        if (F.tid < 384) { const int i = F.tid / 6, c6 = F.tid % 6;
            *(LAS v4u*)(QI + i * 56 + c6 * 8) = *(const GAS v4u*)(QIN + (size_t)u * 3072 + i * GDK + c6 * 8); *(LAS v4u*)(KI + i * 56 + c6 * 8) = *(const GAS v4u*)(KIN + (size_t)u * 3072 + i * GDK + c6 * 8); }
        for (int idx = F.tid; idx < 768; idx += 512) { const int j = idx & 63, c12 = idx >> 6; const v4u v8 = *(const GAS v4u*)(Z + (size_t)(row0 + j) * NZ + 1536 + h * GDV + c12 * 8);
            const unsigned w[4] = {v8.x, v8.y, v8.z, v8.w};
#pragma unroll
            for (int e = 0; e < 8; ++e) VT[(c12 * 8 + e) * 72 + j] = (bf16)((w[e >> 1] >> ((e & 1) * 16)) & 0xffffu); }
        for (int idx = F.tid; idx < 576; idx += 512) { const int v = idx / 6, c6 = idx % 6; *(LAS v4u*)(STT + v * 56 + c6 * 8) = *(const GAS v4u*)(ST + (size_t)u * (GDK * GDV) + v * GDK + c6 * 8); }
        WG_SYNC();
        if (F.wave < 6) { const int it = F.wave / 3, vt = F.wave % 3;
            bf16x8 qf[3];
#pragma unroll
            for (int s = 0; s < 3; ++s) qf[s] = *(const LAS bf16x8*)(QI + (32 * it + r32) * 56 + 16 * s + 8 * hi);
            f32x16 O = {};
            for (int jt = 0; jt <= it; ++jt) { f32x16 P = {};
#pragma unroll
                for (int s = 0; s < 3; ++s) { const bf16x8 kf = *(const LAS bf16x8*)(KI + (32 * jt + r32) * 56 + 16 * s + 8 * hi); P = mfma32(kf, qf[s], P); }
                if (jt == it) {
#pragma unroll
                    for (int r = 0; r < 16; ++r) if (crow(r, hi) > r32) P[r] = 0.f; }
                v4u pa0, pa1; pa0.x = pk2(P[0], P[1]); pa0.y = pk2(P[2], P[3]); pa0.z = pk2(P[4], P[5]); pa0.w = pk2(P[6], P[7]); pa1.x = pk2(P[8], P[9]); pa1.y = pk2(P[10], P[11]); pa1.z = pk2(P[12], P[13]); pa1.w = pk2(P[14], P[15]);
#pragma unroll
                for (int s2 = 0; s2 < 2; ++s2) { const LAS bf16* vp = VT + (32 * vt + r32) * 72 + 32 * jt + 16 * s2 + 4 * hi;
                    const u16x4 lo = *(const LAS u16x4*)vp, hh = *(const LAS u16x4*)(vp + 8);
                    const bf16x8 vb = (bf16x8){(short)lo[0], (short)lo[1], (short)lo[2], (short)lo[3], (short)hh[0], (short)hh[1], (short)hh[2], (short)hh[3]};
                    O = mfma32(__builtin_bit_cast(bf16x8, s2 ? pa1 : pa0), vb, O); } }
#pragma unroll
            for (int s = 0; s < 3; ++s) { const bf16x8 sf = *(const LAS bf16x8*)(STT + (32 * vt + r32) * 56 + 16 * s + 8 * hi); O = mfma32(qf[s], sf, O); }
#pragma unroll
            for (int r = 0; r < 16; ++r) OB[(32 * it + crow(r, hi)) * 97 + 32 * vt + r32] = O[r]; }
        WG_SYNC();
        { const int i = F.tid >> 3, part = F.tid & 7; float x[12]; float ss = 0.f;
#pragma unroll
          for (int e = 0; e < 12; ++e) { x[e] = OB[i * 97 + part * 12 + e]; ss += x[e] * x[e]; }
          ss += __shfl_xor(ss, 1); ss += __shfl_xor(ss, 2); ss += __shfl_xor(ss, 4);
          const float rstd = 1.0f / sqrtf(ss * (1.0f / GDV) + RMS_EPS);
          const GAS unsigned long long* grp = (const GAS unsigned long long*)(Z + (size_t)(row0 + i) * NZ + 1920 + h * GDV + part * 12);
          GAS unsigned long long* op = (GAS unsigned long long*)(MIX + (size_t)(row0 + i) * D + 384 + h * GDV + part * 12);
          const float* gp = gng + h * GDV + part * 12;
#pragma unroll
          for (int q = 0; q < 3; ++q) { const unsigned long long w = grp[q]; const unsigned lo = (unsigned)w, hh = (unsigned)(w >> 32);
              const float o0 = x[4 * q] * rstd * gp[4 * q] * siluf(bf2f(lo & 0xffffu)), o1 = x[4 * q + 1] * rstd * gp[4 * q + 1] * siluf(bf2f(lo >> 16));
              const float o2 = x[4 * q + 2] * rstd * gp[4 * q + 2] * siluf(bf2f(hh & 0xffffu)), o3 = x[4 * q + 3] * rstd * gp[4 * q + 3] * siluf(bf2f(hh >> 16));
              op[q] = (unsigned long long)pk2(o0, o1) | ((unsigned long long)pk2(o2, o3) << 32); } }
        WG_SYNC();
    }
}
__device__ __forceinline__ void ph_mixer_queue(Frame& F, int l, const float* const* in, char* lds_generic, const bf16* wpt, const float* ps, const float* gng) {
    gu32* q = F.ctl + CW_TAILQ + l * 64; gu32* qv = F.ctl + CW_CONVQ + l * 64; gu32* done = F.ctl + CW_SCAN + l * 64; gu32* nrm = F.ctl + CW_NRM + l * 64;
    const attn_body::bf16* Z = (const attn_body::bf16*)(F.ws + WS_Z); const float* FC = (const float*)(F.ws + WS_FCUM); attn_body::bf16* MIX = (attn_body::bf16*)(F.ws + WS_MIX);
    LAS int* slot = (LAS int*)(F.lds + LX_SCR + 2048);
    constexpr int NATT = BATCH * FOXH * 32, NCOMP = NATT + NPOOLU + NGLA3U;
    const bool has_conv = true;
    const int nstatic = F.G - (has_conv ? 128 : 0);
    bool comp_left = true, conv_left = has_conv, scan_ok = false;
    int mode = ((int)blockIdx.x >= nstatic) ? 1 : 0;
    int item = (int)blockIdx.x; unsigned nxt = 0u;
    if (mode == 0 && F.tid == 0) nxt = (unsigned)nstatic + __hip_atomic_fetch_add(q, 1u, RLX_AGENT);
    for (;;) {
        if (mode == 0) {
            if (!comp_left) { if (conv_left) { mode = 1; continue; } break; }
            if (item >= NCOMP) { comp_left = false; continue; }
            if (item < NATT) { const int qb = 31 - item / (BATCH * FOXH), bh = item % (BATCH * FOXH);
                const float q2 = __uint_as_float(__hip_atomic_load(nrm + bh, RLX_AGENT)), k2 = __uint_as_float(__hip_atomic_load(nrm + 12 + bh, RLX_AGENT));
                attn_body::attn_unit<8>(bh / FOXH, bh % FOXH, qb, Z, FC, sqrtf(q2 * k2) * 1.01f, MIX, lds_generic); }
            else if (item < NATT + NPOOLU) pool_unit(F, item - NATT, wpt, ps);
            else {
                if (!scan_ok) {
                    if (F.tid < 64) { unsigned sp = 0;
                        while ((unsigned)__builtin_amdgcn_readfirstlane(__hip_atomic_load(done, RLX_AGENT)) < (unsigned)NSCANBLK) { __builtin_amdgcn_s_sleep(2); if (++sp > (1u << 22)) break; }
                        __builtin_amdgcn_fence(__ATOMIC_ACQUIRE, "agent"); asm volatile("s_waitcnt vmcnt(0)" ::: "memory"); }
                    WG_SYNC(); scan_ok = true; }
                gla3_unit(F, item - NATT - NPOOLU, gng); }
            if (F.tid == 0) *slot = (int)nxt;
            WG_SYNC();
            item = __builtin_amdgcn_readfirstlane(*slot);
            if (F.tid == 0) nxt = (unsigned)nstatic + __hip_atomic_fetch_add(q, 1u, RLX_AGENT);
            REFRESH_F();
        } else {
            if (!conv_left) {
                if (!comp_left) break;
                mode = 0;
                if (F.tid == 0) { *slot = (int)((unsigned)nstatic + __hip_atomic_fetch_add(q, 1u, RLX_AGENT)); nxt = (unsigned)nstatic + __hip_atomic_fetch_add(q, 1u, RLX_AGENT); }
                WG_SYNC();
                item = __builtin_amdgcn_readfirstlane(*slot);
                WG_SYNC();
                continue; }
            conv_run(F, in, l, qv, slot);
            conv_left = false;
            REFRESH_F();
        }
    }
}
template <int R>
__device__ __forceinline__ void ph_ln1_router(Frame& F, int l, int cslot, const float* const* in) {
    const int gw = F.vcu * NWAVES + F.wave, NGW = F.G * NWAVES, lane = F.lane;
    const float* mod = (const float*)(F.ws + WS_MOD) + (size_t)l * 2 * 6144;
    const bf16* Xin = (const bf16*)(F.ws + WS_X0); const bf16* Y = (const bf16*)(F.ws + WS_Y); bf16* X1 = (bf16*)(F.ws + WS_X1); unsigned char* H2 = F.ws + WS_H2;
    const float* g1 = in[12] + (size_t)l * D; const float* b1 = in[13] + (size_t)l * D; const float* br = in[15] + (size_t)l * NE;
    int* TOKE = (int*)(F.ws + WS_TOKE); int* TOKS = (int*)(F.ws + WS_TOKS); float* TOKG = (float*)(F.ws + WS_TOKG); int* LIST = (int*)(F.ws + WS_LIST);
    LAS float* wrT = (LAS float*)(F.lds + RING_OFF);
    LAS int* hist = (LAS int*)(F.lds + LX_HIST); LAS int* hbase = hist + 32;
    LAS float* lsc = (LAS float*)(F.lds + LX_SCR) + F.wave * 64;
    { const float* wt = (const float*)(F.ws + WS_WRT) + (size_t)l * NE * D;
      for (int idx = F.tid; idx < NE * D / 4; idx += 512) ((LAS f32x4*)wrT)[idx] = ((const f32x4*)wt)[idx];
      if (F.tid < 32) hist[F.tid] = 0; }
    WG_SYNC();
    unsigned long long xn[R][4], yn[R][4];
#define LN1_LOAD(mm) do { _Pragma("unroll") for (int rr = 0; rr < R; ++rr) { const GAS unsigned long long* xr = (const GAS unsigned long long*)(Xin + (size_t)((mm) + rr) * D) + lane; const GAS unsigned long long* yr = (const GAS unsigned long long*)(Y + (size_t)((mm) + rr) * D) + lane; \
        _Pragma("unroll") for (int j = 0; j < 4; ++j) { xn[rr][j] = __builtin_nontemporal_load((const unsigned long long*)(xr + 64 * j)); yn[rr][j] = __builtin_nontemporal_load((const unsigned long long*)(yr + 64 * j)); } } } while (0)
    if (gw * R < T) LN1_LOAD(gw * R);
    for (int m0 = gw * R; m0 < T; m0 += NGW * R) {
        const int b = m0 >> 13; const float* mb = mod + (size_t)b * 6144;
        f32x4 v[R][4]; float mean[R], rstd[R];
#pragma unroll
        for (int rr = 0; rr < R; ++rr) {
#pragma unroll
            for (int j = 0; j < 4; ++j) { const int c0 = 256 * j + 4 * lane; const f32x4 gt = *(const f32x4*)(mb + 2048 + c0); v[rr][j] = bf4_to_f32(xn[rr][j]) * DN_ALPHA + (gt + 1.0f) * bf4_to_f32(yn[rr][j]); } }
        if (m0 + NGW * R < T) LN1_LOAD(m0 + NGW * R);
#pragma unroll
        for (int rr = 0; rr < R; ++rr) { float s = 0.f;
#pragma unroll
            for (int j = 0; j < 4; ++j) s += (v[rr][j].x + v[rr][j].y) + (v[rr][j].z + v[rr][j].w);
            mean[rr] = s; }
#pragma unroll
        for (int rr = 0; rr < R; ++rr) mean[rr] = wave_sum(mean[rr]);
#pragma unroll
        for (int rr = 0; rr < R; ++rr) { mean[rr] *= (1.f / D); float s2 = 0.f;
#pragma unroll
            for (int j = 0; j < 4; ++j) { v[rr][j] = v[rr][j] - mean[rr]; s2 += (v[rr][j].x * v[rr][j].x + v[rr][j].y * v[rr][j].y) + (v[rr][j].z * v[rr][j].z + v[rr][j].w * v[rr][j].w); }
            rstd[rr] = s2; }
#pragma unroll
        for (int rr = 0; rr < R; ++rr) rstd[rr] = wave_sum(rstd[rr]);
#pragma unroll
        for (int rr = 0; rr < R; ++rr) { rstd[rr] = 1.f / sqrtf(rstd[rr] * (1.f / D) + LN_EPS);
            GAS unsigned long long* x1r = (GAS unsigned long long*)(X1 + (size_t)(m0 + rr) * D) + lane;
            GAS unsigned* o4 = (GAS unsigned*)(H2 + (size_t)(m0 + rr) * D) + lane;
#pragma unroll
            for (int j = 0; j < 4; ++j) { const int c0 = 256 * j + 4 * lane;
                const f32x4 x1 = v[rr][j] * rstd[rr] * *(const f32x4*)(g1 + c0) + *(const f32x4*)(b1 + c0);
                __builtin_nontemporal_store(f32_to_bf4(x1), (unsigned long long*)(x1r + 64 * j));
                const f32x4 h = x1 * (*(const f32x4*)(mb + 4096 + c0) + 1.0f) + *(const f32x4*)(mb + 3072 + c0);
                v[rr][j] = h;
                o4[64 * j] = pg8::pk4_fp8(h.x, h.y, h.z, h.w); } }
        float p[R][32];
        { typedef float lf2 __attribute__((ext_vector_type(2)));
          lf2 vv[R / 2][4][4];
#pragma unroll
          for (int q = 0; q < R / 2; ++q)
#pragma unroll
              for (int j = 0; j < 4; ++j)
#pragma unroll
                  for (int c = 0; c < 4; ++c) vv[q][j][c] = (lf2){v[2 * q][j][c], v[2 * q + 1][j][c]};
          const LAS f32x4* wp = (const LAS f32x4*)wrT + lane;
          f32x4 wq[4];
#pragma unroll
          for (int g = 0; g < 3; ++g) wq[g] = wp[(g >> 2) * 256 + 64 * (g & 3)];
          lf2 a0[R / 2], a1[R / 2];
#pragma unroll
          for (int g = 0; g < 128; ++g) { const int e = g >> 2, j = g & 3;
              if (g + 3 < 128) wq[(g + 3) & 3] = wp[((g + 3) >> 2) * 256 + 64 * ((g + 3) & 3)];
              __builtin_amdgcn_sched_barrier(0);
              const lf2 wlo = __builtin_shufflevector(wq[g & 3], wq[g & 3], 0, 1), whi = __builtin_shufflevector(wq[g & 3], wq[g & 3], 2, 3);
#pragma unroll
              for (int q = 0; q < R / 2; ++q) {
                  if (j == 0) asm("v_pk_mul_f32 %0, %2, %6 op_sel_hi:[1,0]\n\tv_pk_mul_f32 %1, %3, %6 op_sel:[0,1] op_sel_hi:[1,1]\n\tv_pk_fma_f32 %0, %4, %7, %0 op_sel_hi:[1,0,1]\n\tv_pk_fma_f32 %1, %5, %7, %1 op_sel:[0,1,0] op_sel_hi:[1,1,1]"
                                  : "=&v"(a0[q]), "=&v"(a1[q]) : "v"(vv[q][j][0]), "v"(vv[q][j][1]), "v"(vv[q][j][2]), "v"(vv[q][j][3]), "v"(wlo), "v"(whi));
                  else asm("v_pk_fma_f32 %0, %2, %6, %0 op_sel_hi:[1,0,1]\n\tv_pk_fma_f32 %1, %3, %6, %1 op_sel:[0,1,0] op_sel_hi:[1,1,1]\n\tv_pk_fma_f32 %0, %4, %7, %0 op_sel_hi:[1,0,1]\n\tv_pk_fma_f32 %1, %5, %7, %1 op_sel:[0,1,0] op_sel_hi:[1,1,1]"
                           : "+v"(a0[q]), "+v"(a1[q]) : "v"(vv[q][j][0]), "v"(vv[q][j][1]), "v"(vv[q][j][2]), "v"(vv[q][j][3]), "v"(wlo), "v"(whi));
                  if (j == 3) { const lf2 t = a0[q] + a1[q]; p[2 * q][e] = t.x; p[2 * q + 1][e] = t.y; } }
              __builtin_amdgcn_sched_barrier(0);
          } }
#define DPPF(v, ctrl) __builtin_bit_cast(float, __builtin_amdgcn_update_dpp(0, __builtin_bit_cast(int, (v)), (ctrl), 0xf, 0xf, false))
#pragma unroll
        for (int rr = 0; rr < R; ++rr) {
#pragma unroll
            for (int i = 0; i < 16; ++i) { auto r2 = __builtin_amdgcn_permlane32_swap(__float_as_uint(p[rr][i]), __float_as_uint(p[rr][i + 16]), false, false); p[rr][i] = __uint_as_float(r2[0]) + __uint_as_float(r2[1]); }
#pragma unroll
            for (int i = 0; i < 8; ++i) { auto r2 = __builtin_amdgcn_permlane16_swap(__float_as_uint(p[rr][i]), __float_as_uint(p[rr][i + 8]), false, false); p[rr][i] = __uint_as_float(r2[0]) + __uint_as_float(r2[1]); }
#pragma unroll
            for (int i = 0; i < 4; ++i) { const bool up = (lane & 8) != 0; const float keep = up ? p[rr][i + 4] : p[rr][i], send = up ? p[rr][i] : p[rr][i + 4]; p[rr][i] = keep + DPPF(send, 0x128  ); }
#pragma unroll
            for (int i = 0; i < 2; ++i) { const bool up = (lane & 4) != 0; const float keep = up ? p[rr][i + 2] : p[rr][i], send = up ? p[rr][i] : p[rr][i + 2]; p[rr][i] = keep + __shfl_xor(send, 4); }
            { const bool up = (lane & 2) != 0; const float keep = up ? p[rr][1] : p[rr][0], send = up ? p[rr][0] : p[rr][1]; p[rr][0] = keep + DPPF(send, 0x4E  ); }
            p[rr][0] += DPPF(p[rr][0], 0xB1  );
        }
#pragma unroll
        for (int rr = 0; rr < R; ++rr) {
            const int m = m0 + rr;
            if ((lane & 1) == 0) lsc[lane >> 1] = p[rr][0] + br[lane >> 1];
            LDS_WAIT(); asm volatile("" ::: "memory");
            const int me = lane & 31; const float my = lsc[me]; int rank = 0;
#pragma unroll
            for (int e4 = 0; e4 < 8; ++e4) { const f32x4 q4 = *(const LAS f32x4*)(lsc + 4 * e4);
#pragma unroll
                for (int j = 0; j < 4; ++j) { const int e = 4 * e4 + j; rank += (q4[j] > my || (q4[j] == my && e < me)) ? 1 : 0; } }
            if (lane < 32 && rank < 4) { lsc[32 + rank] = my; ((LAS int*)lsc)[36 + rank] = me; }
            LDS_WAIT(); asm volatile("" ::: "memory");
            const f32x4 sv = *(const LAS f32x4*)(lsc + 32);
            const float e1 = __expf(sv[1] - sv[0]), e2 = __expf(sv[2] - sv[0]), e3 = __expf(sv[3] - sv[0]); const float inv = 1.0f / (1.0f + e1 + e2 + e3);
            if (lane < 4) { const int e = ((LAS int*)lsc)[36 + lane]; const float gte = (lane == 0 ? 1.0f : lane == 1 ? e1 : lane == 2 ? e2 : e3) * inv;
                const int rnk = atomicAdd((int*)(hist + e), 1);
                TOKE[(size_t)m * 4 + lane] = e; TOKS[(size_t)m * 4 + lane] = rnk; TOKG[(size_t)m * 4 + lane] = gte; }
            LDS_WAIT(); asm volatile("" ::: "memory");
        }
#undef DPPF
    }
    WG_SYNC();
    if (F.tid < 32) hbase[F.tid] = (int)__hip_atomic_fetch_add((unsigned*)(F.ctl + CW_CNT + (cslot * 32 + F.tid) * 64), (unsigned)hist[F.tid], RLX_AGENT);
    WG_SYNC();
    for (int m0 = gw * R; m0 < T; m0 += NGW * R) { if (lane < 4 * R) { const size_t q = (size_t)m0 * 4 + lane; const int e = TOKE[q], slot = TOKS[q] + hbase[e]; TOKS[q] = slot; LIST[e * 16384 + slot] = m0 + (lane >> 2); } }
#undef LN1_LOAD
}
__device__ __forceinline__ int moe_tables(Frame& F, int l) {
    LAS int* tab = (LAS int*)(F.lds + LX_TAB); LAS int* pst = (LAS int*)(F.lds + LX_PST); LAS int* cntl = (LAS int*)(F.lds + LX_CNT);
    if (F.tid < NE) cntl[F.tid] = (int)__hip_atomic_load((unsigned*)(F.ctl + CW_CNT + (l * 32 + F.tid) * 64), RLX_AGENT);
    WG_SYNC();
    if (F.tid == 0) { int run = 0;
#pragma unroll 1
        for (int e = 0; e < NE; ++e) { const int c = cntl[e]; const int nt = (c + 255) >> 8;
            pst[e] = run * 256; for (int k = 0; k < nt; ++k) tab[run + k] = e; run += nt; }
        pst[NE] = run; }
    WG_SYNC();
    return pst[NE];
}
template <int R>
__device__ __forceinline__ void ph_ln2(Frame& F, int l, float* xout, const float* const* in) {
    if (!MK_ONE_LAUNCH) (void)moe_tables(F, l);
    LAS int* pst = (LAS int*)(F.lds + LX_PST);
    const int gw = F.vcu * NWAVES + F.wave, NGW = F.G * NWAVES, lane = F.lane;
    const float* mod = (const float*)(F.ws + WS_MOD) + (size_t)l * 2 * 6144;
    const bf16* X1 = (const bf16*)(F.ws + WS_X1); bf16* X0 = (bf16*)(F.ws + WS_X0); bf16* H = (bf16*)(F.ws + WS_H); const bf16* YR = (const bf16*)(F.ws + WS_YROWS);
    const float* g2 = in[20] + (size_t)l * D; const float* b2 = in[21] + (size_t)l * D;
    const int* TOKE = (const int*)(F.ws + WS_TOKE); const int* TOKS = (const int*)(F.ws + WS_TOKS); const float* TOKG = (const float*)(F.ws + WS_TOKG);
    int rowA[R][4], rowB[R][4]; float gkA[R][4], gkB[R][4]; unsigned long long yd[R][4][4]; unsigned long long xd[R][4];
#define LN2_IDX(mm, ROW, GK) do { _Pragma("unroll") for (int rr = 0; rr < R; ++rr) _Pragma("unroll") for (int k = 0; k < 4; ++k) { const size_t q = (size_t)((mm) + rr) * 4 + k; ROW[rr][k] = pst[TOKE[q]] + TOKS[q]; GK[rr][k] = TOKG[q]; } } while (0)
#define LN2_DATA(mm, ROW) do { _Pragma("unroll") for (int rr = 0; rr < R; ++rr) { _Pragma("unroll") for (int k = 0; k < 4; ++k) { const GAS unsigned long long* yr = (const GAS unsigned long long*)(YR + (size_t)ROW[rr][k] * D) + lane; \
            _Pragma("unroll") for (int j = 0; j < 4; ++j) yd[rr][k][j] = __builtin_nontemporal_load((const unsigned long long*)(yr + 64 * j)); } \
        const GAS unsigned long long* xr = (const GAS unsigned long long*)(X1 + (size_t)((mm) + rr) * D) + lane; _Pragma("unroll") for (int j = 0; j < 4; ++j) xd[rr][j] = __builtin_nontemporal_load((const unsigned long long*)(xr + 64 * j)); } } while (0)
    const int mstep = NGW * R;
    if (gw * R < T) { LN2_IDX(gw * R, rowA, gkA); LN2_DATA(gw * R, rowA); }
    if (gw * R + mstep < T) LN2_IDX(gw * R + mstep, rowB, gkB);
    for (int m0 = gw * R; m0 < T; m0 += mstep) {
        const int b = m0 >> 13; const float* mb = mod + (size_t)b * 6144;
        f32x4 v[R][4]; float mean[R], rstd[R];
#pragma unroll
        for (int rr = 0; rr < R; ++rr) {
            f32x4 y[4];
#pragma unroll
            for (int j = 0; j < 4; ++j) y[j] = (f32x4){0.f, 0.f, 0.f, 0.f};
#pragma unroll
            for (int k = 0; k < 4; ++k) { const float g = gkA[rr][k];
#pragma unroll
                for (int j = 0; j < 4; ++j) { const unsigned long long w = yd[rr][k][j]; const unsigned lo = (unsigned)w, hi = (unsigned)(w >> 32);
                    y[j].x += g * bf2f(lo & 0xffffu); y[j].y += g * bf2f(lo >> 16); y[j].z += g * bf2f(hi & 0xffffu); y[j].w += g * bf2f(hi >> 16); } }
            float s = 0.f;
#pragma unroll
            for (int j = 0; j < 4; ++j) { const int c0 = 256 * j + 4 * lane; const f32x4 gt = *(const f32x4*)(mb + 5120 + c0);
                v[rr][j] = bf4_to_f32(xd[rr][j]) * DN_ALPHA + (gt + 1.0f) * y[j]; s += (v[rr][j].x + v[rr][j].y) + (v[rr][j].z + v[rr][j].w); }
            mean[rr] = s; }
#pragma unroll
        for (int rr = 0; rr < R; ++rr)
#pragma unroll
            for (int k = 0; k < 4; ++k) { rowA[rr][k] = rowB[rr][k]; gkA[rr][k] = gkB[rr][k]; }
        if (m0 + mstep < T) LN2_DATA(m0 + mstep, rowA);
        if (m0 + 2 * mstep < T) LN2_IDX(m0 + 2 * mstep, rowB, gkB);
#pragma unroll
        for (int rr = 0; rr < R; ++rr) mean[rr] = wave_sum(mean[rr]);
#pragma unroll
        for (int rr = 0; rr < R; ++rr) { mean[rr] *= (1.f / D); float s2 = 0.f;
#pragma unroll
            for (int j = 0; j < 4; ++j) { v[rr][j] = v[rr][j] - mean[rr]; s2 += (v[rr][j].x * v[rr][j].x + v[rr][j].y * v[rr][j].y) + (v[rr][j].z * v[rr][j].z + v[rr][j].w * v[rr][j].w); }
            rstd[rr] = s2; }
#pragma unroll
        for (int rr = 0; rr < R; ++rr) rstd[rr] = wave_sum(rstd[rr]);
        const float* mn = mod + 2 * 6144 + (size_t)b * 6144;
#pragma unroll
        for (int rr = 0; rr < R; ++rr) { rstd[rr] = 1.f / sqrtf(rstd[rr] * (1.f / D) + LN_EPS);
            GAS f32x4* xo = (GAS f32x4*)(xout + (size_t)(m0 + rr) * D) + lane; GAS unsigned long long* xb = (GAS unsigned long long*)(X0 + (size_t)(m0 + rr) * D) + lane;
            GAS unsigned long long* o8 = (GAS unsigned long long*)(H + (size_t)(m0 + rr) * D) + lane;
#pragma unroll
            for (int j = 0; j < 4; ++j) { const int c0 = 256 * j + 4 * lane;
                const f32x4 x = v[rr][j] * rstd[rr] * *(const f32x4*)(g2 + c0) + *(const f32x4*)(b2 + c0);
                if (l + 1 == DEPTH) xo[64 * j] = x; else __builtin_nontemporal_store(f32_to_bf4(x), (unsigned long long*)(xb + 64 * j));
                if (l + 1 < DEPTH) { const f32x4 h = x * (*(const f32x4*)(mn + 1024 + c0) + 1.0f) + *(const f32x4*)(mn + c0);
                    o8[64 * j] = (unsigned long long)pk2(h.x, h.y) | ((unsigned long long)pk2(h.z, h.w) << 32); } } }
    }
#undef LN2_IDX
#undef LN2_DATA
}

constexpr int PH_CONV = 0, PH_MODFIN = 1, PH_MOD0 = 2, PH_L0 = 3, PH_PER_LAYER = 7, NPH = PH_L0 + DEPTH * PH_PER_LAYER;
struct Args { const float* in[22]; float* out; unsigned char* ws; int ph_lo, ph_hi; };
__global__ void __launch_bounds__(NWAVES * 64, 2) fwd_kernel(Args args) {
    extern __shared__ __attribute__((aligned(16))) unsigned char lds[];
    Frame F;
    F.lds = (LAS unsigned char*)lds;
    F.MISC = (volatile LAS unsigned*)(F.lds + MISC_OFF);
    F.tid = threadIdx.x; F.lane = F.tid & 63; F.wave = __builtin_amdgcn_readfirstlane(F.tid >> 6);
    F.G = gridDim.x; { const int bx = blockIdx.x; F.vcu = (F.G % 8 == 0) ? (bx % 8) * (F.G / 8) + bx / 8 : bx; }
    F.ws = args.ws; F.ctl = (gu32*)(args.ws + WS_CTL);
    for (int u = F.tid; u < (LDS_BYTES - LDSCTL_OFF) / 4; u += NWAVES * 64) ((LAS unsigned*)(F.lds + LDSCTL_OFF))[u] = 0u;
    __syncthreads();
    XcdBarrier bar; bar.bar = (unsigned*)(F.ctl + CW_BAR); bar.x = 0; bar.st = nullptr;
    if (MK_ONE_LAUNCH) bar = xcd_barrier_post((unsigned*)(F.ctl + CW_BAR), F.MISC + 8);
    const int lo = args.ph_lo, hi = args.ph_hi;
#define IN(k) (lo <= (k) && (k) < hi)
#ifndef PROBE_DUP
#define PROBE_DUP 0
#endif
#define REP(k) _Pragma("unroll 1") for (int rep_ = 0; rep_ < (((PROBE_DUP >> (k)) & 1) ? 2 : 1); ++rep_)
#define REFRESH() do { F.tid = opaque_tid(); F.lane = F.tid & 63; F.wave = __builtin_amdgcn_readfirstlane(F.tid >> 6); } while (0)
#define SEAM(k) do { if (MK_ONE_LAUNCH && IN(k) && IN((k) + 1)) xcd_barrier(bar); } while (0)
    const float* const* in = args.in;

    if (IN(PH_CONV)) {
#ifndef NO_CONV
 REP(10) { REFRESH(); ph_convert(F, in); }
#endif
 } SEAM(PH_CONV);
    if (IN(PH_MODFIN)) { REFRESH(); ph_modfin(F, in); } SEAM(PH_MODFIN);
    if (IN(PH_MOD0)) { REFRESH(); ph_mod0(F, in[0]); } SEAM(PH_MOD0);

    for (int l = 0; l < DEPTH; ++l) {
        const int pb = PH_L0 + l * PH_PER_LAYER;
        float* xout = args.out;
        if (IN(pb + 0)) {
#ifndef NO_G0
 REP(0) {            pg8::Gemm g{(const pg8::bf16_t*)(F.ws + WS_H), (const pg8::bf16_t*)(F.ws + WS_WIN) + (size_t)l * NINP * D, T, NINP, D};
            pg8::StaticOrder S; S.init(T, NINP, F.G, (int)blockIdx.x);
            pg8::EpiZ E{(pg8::bf16_t*)(F.ws + WS_Z), (float*)(F.ws + WS_ZF), (const float*)(F.ws + WS_BINP) + (size_t)l * NINP, (float*)(F.ws + WS_LF)};
            pg8::gemm_phase<pg8::EpiZ, pg8::StaticOrder, true, false>(F.lds + RING_OFF, g, S, E); }
#endif
        } SEAM(pb + 0);
        if (IN(pb + 1)) {
#ifndef NO_PRE
            REFRESH(); ph_fcum(F);
            REFRESH(); ph_qknorm(F, F.ctl + CW_NRM + l * 64);
            REFRESH(); ph_gla1(F, in[6] + (size_t)l * 16 * 192, in[7] + (size_t)l * 192);
#endif
        } SEAM(pb + 1);
        if (IN(pb + 2)) {
#ifndef NO_ATT
            REFRESH(); ph_glascan(F, F.ctl + CW_SCAN + l * 64);
            REFRESH(); ph_mixer_queue(F, l, in, (char*)lds + RING_OFF, (const bf16*)(F.ws + WS_WPT) + (size_t)l * 4 * 64 * 64, in[10] + (size_t)l * 256, in[8] + (size_t)l * 384);
#endif
        } SEAM(pb + 2);
        if (IN(pb + 3)) {
#ifndef NO_G4
 REP(4) {            pg8::Gemm g{(const pg8::bf16_t*)(F.ws + WS_MIX), (const pg8::bf16_t*)(F.ws + WS_WOUT) + (size_t)l * D * D, T, D, D};
            pg8::StaticOrder S; S.init(T, D, F.G, (int)blockIdx.x);
            pg8::EpiY E{(pg8::bf16_t*)(F.ws + WS_Y)};
            pg8::gemm_phase<pg8::EpiY, pg8::StaticOrder, true, false>(F.lds + RING_OFF, g, S, E); }
#endif
        } SEAM(pb + 3);
        if (IN(pb + 4)) {
#ifndef NO_LN1
 REP(5) { REFRESH(); ph_ln1_router<2>(F, l, (rep_ + 1 < (((PROBE_DUP >> 5) & 1) ? 2 : 1)) ? l + 4 : l, in); }
#endif
 } SEAM(pb + 4);
        if (IN(pb + 5)) {
#if !defined(NO_G7)
            REFRESH(); const int Mt = __builtin_amdgcn_readfirstlane(moe_tables(F, l));
            unsigned* rdy = (unsigned*)(F.ctl + CW_RDY + l * (320 * 64));
            { pg8::Gemm g{(const pg8::bf16_t*)(F.ws + WS_H2), (const pg8::bf16_t*)(F.ws + WS_WGU + (size_t)l * NE * 2048 * D), MROWS, 2048, D / 2};
              pg8::MoeOrder<8, 1> S{(const LAS int*)(F.lds + LX_TAB), (const LAS int*)(F.lds + LX_PST), (const LAS int*)(F.lds + LX_CNT), (const int*)(F.ws + WS_LIST), Mt, F.G, (int)blockIdx.x, rdy, 0};
              pg8::EpiSwiglu E{F.ws + WS_ACT, in[17] + (size_t)l * NE * 2048};
              pg8::gemm_phase<pg8::EpiSwiglu, pg8::MoeOrder<8, 1>, true, true, true>(F.lds + RING_OFF, g, S, E, 0x7a7a7a7a); }
            { REFRESH();
              const int extra = (Mt * 8) % F.G;
              const int xsh = (((Mt + 7) >> 3) * 2) & 7;
              pg8::Gemm g{(const pg8::bf16_t*)(F.ws + WS_ACT), (const pg8::bf16_t*)(F.ws + WS_WDN + (size_t)l * NE * D * D), MROWS, D, D / 2};
              pg8::MoeOrder<4, 2> S{(const LAS int*)(F.lds + LX_TAB), (const LAS int*)(F.lds + LX_PST), (const LAS int*)(F.lds + LX_CNT), (const int*)(F.ws + WS_LIST), Mt, F.G, F.G == 256 ? (int)blockIdx.x : ((int)blockIdx.x - extra + F.G) % F.G, rdy, xsh};
              pg8::EpiDown E{(pg8::bf16_t*)(F.ws + WS_YROWS), in[19] + (size_t)l * NE * D};
              pg8::gemm_phase<pg8::EpiDown, pg8::MoeOrder<4, 2>, true, false, true>(F.lds + RING_OFF, g, S, E, 0x79797979); }
#endif
        } SEAM(pb + 5);
        if (IN(pb + 6)) {
#ifndef NO_LN2
 REP(9) { REFRESH(); ph_ln2<1>(F, l, xout, in); }
#endif
 } SEAM(pb + 6);
    }
#undef IN
#undef SEAM
}

extern "C" void kernel_launch(void* const* d_in, const int* in_sizes, int n_in, void* d_out, int out_size, void* d_ws, size_t ws_size, hipStream_t stream) {
    static int grid = 0;
    if (grid == 0) {
        if (n_in != 22 || in_sizes[0] != T * D || out_size != T * D || ws_size < WS_END) { fprintf(stderr, "kernel_launch: unexpected shapes (n_in %d, in0 %d, out %d, ws %zu)\n", n_in, n_in > 0 ? in_sizes[0] : -1, out_size, ws_size); grid = -1; return; }
        int dev = 0, cus = 0, per_cu = 0;
        if (hipGetDevice(&dev) != hipSuccess || hipDeviceGetAttribute(&cus, hipDeviceAttributeMultiprocessorCount, dev) != hipSuccess) { grid = -1; return; }
        if (hipFuncSetAttribute((const void*)fwd_kernel, hipFuncAttributeMaxDynamicSharedMemorySize, LDS_BYTES) != hipSuccess) { fprintf(stderr, "kernel_launch: hipFuncSetAttribute failed\n"); grid = -1; return; }
        if (hipOccupancyMaxActiveBlocksPerMultiprocessor(&per_cu, (const void*)fwd_kernel, NWAVES * 64, LDS_BYTES) != hipSuccess || per_cu < 1) fprintf(stderr, "kernel_launch: occupancy query reports %d\n", per_cu);
        (void)hipGetLastError();
        grid = cus;
    }
    if (grid < 0) return;
    if (hipMemsetAsync((char*)d_ws + WS_CTL, 0, CTL_ZERO_BYTES, stream) != hipSuccess) return;
    Args a{};
    for (int i = 0; i < 22; ++i) a.in[i] = (const float*)d_in[i];
    a.out = (float*)d_out; a.ws = (unsigned char*)d_ws;
#if MK_ONE_LAUNCH
    a.ph_lo = 0; a.ph_hi = NPH;
    hipLaunchKernelGGL(fwd_kernel, dim3(grid), dim3(NWAVES * 64), LDS_BYTES, stream, a);
#else
    for (int p = 0; p < NPH; ++p) { a.ph_lo = p; a.ph_hi = p + 1; hipLaunchKernelGGL(fwd_kernel, dim3(grid), dim3(NWAVES * 64), LDS_BYTES, stream, a); }
#endif
}
```
